# Optimizing an MI355X kernel written in HIP

```python
import math
import jax, jax.numpy as jnp
from jax import lax
import numpy as np

D_MODEL = 2048
BATCH = 8
SEQ = 2048
DEPTH = 2

CHUNK = 64

MIX_WIDTH = D_MODEL
CONV_CH = MIX_WIDTH // 2
SSM_CH = MIX_WIDTH - CONV_CH
CONV_WIDTH = 31
SSM_GROUP_WIDTH = 16
SSM_GROUPS = SSM_CH // SSM_GROUP_WIDTH
SSM_STATE = 64
IN_COLS = 2 * CONV_CH + 2 * SSM_CH

N_GROUPS = 4
EXPERTS_PER_GROUP = 8
TOP_K = 2
D_EXPERT = 512

EPS = 1e-6

kernel_name = 'hymba_conformer_s5_hmoe_trunk'


def rms_norm(x, g):
    xf = x.astype(jnp.float32)
    y = xf * lax.rsqrt(jnp.mean(xf * xf, axis=-1, keepdims=True) + EPS)
    return (y * g.astype(jnp.float32)).astype(x.dtype)


def layer_norm(x, g, b):
    xf = x.astype(jnp.float32)
    mu = jnp.mean(xf, axis=-1, keepdims=True)
    var = jnp.mean(jnp.square(xf - mu), axis=-1, keepdims=True)
    y = (xf - mu) * lax.rsqrt(var + EPS)
    return (y * g.astype(jnp.float32) + b.astype(jnp.float32)).astype(x.dtype)


def modulate(h, shift, scale):
    return h * (1.0 + scale[:, None, :]) + shift[:, None, :]


def conformer_conv(val, gate, dw_w, dw_b, ln_g, ln_b):
    z = val * jax.nn.sigmoid(gate)
    z = lax.conv_general_dilated(
        z, dw_w[:, None, :].astype(z.dtype), window_strides=(1,),
        padding=[(CONV_WIDTH - 1, 0)],
        dimension_numbers=('NWC', 'WIO', 'NWC'),
        feature_group_count=CONV_CH) + dw_b
    z = layer_norm(z, ln_g, ln_b)
    return jax.nn.silu(z)


def s5_ssm(u, gate, a_re, a_im, b_re, b_im, c_re, c_im, d_skip, log_dt):
    dtype = u.dtype
    bsz, seq, _ = u.shape
    f32 = jnp.float32
    uf = u.astype(f32).reshape(bsz, seq, SSM_GROUPS, SSM_GROUP_WIDTH)
    dt = jnp.exp(log_dt.astype(f32))[:, None]
    lr, li = a_re.astype(f32), a_im.astype(f32)
    mag = jnp.exp(lr * dt)
    ang = li * dt
    abar_re, abar_im = mag * jnp.cos(ang), mag * jnp.sin(ang)
    den = lr * lr + li * li
    nr, ni = abar_re - 1.0, abar_im
    f_re = (nr * lr + ni * li) / den
    f_im = (ni * lr - nr * li) / den
    br, bi = b_re.astype(f32), b_im.astype(f32)
    bb_re = f_re[..., None] * br - f_im[..., None] * bi
    bb_im = f_re[..., None] * bi + f_im[..., None] * br
    bu_re = jnp.einsum('blgh,gph->blgp', uf, bb_re)
    bu_im = jnp.einsum('blgh,gph->blgp', uf, bb_im)
    a_seq_re = jnp.broadcast_to(abar_re, (1, seq, SSM_GROUPS, SSM_STATE))
    a_seq_im = jnp.broadcast_to(abar_im, (1, seq, SSM_GROUPS, SSM_STATE))

    def combine(e1, e2):
        a1r, a1i, b1r, b1i = e1
        a2r, a2i, b2r, b2i = e2
        ar = a1r * a2r - a1i * a2i
        ai = a1r * a2i + a1i * a2r
        brr = a2r * b1r - a2i * b1i + b2r
        bii = a2r * b1i + a2i * b1r + b2i
        return (ar, ai, brr, bii)

    _, _, s_re, s_im = lax.associative_scan(combine, (a_seq_re, a_seq_im, bu_re, bu_im), axis=1)
    y = (jnp.einsum('blgp,ghp->blgh', s_re, c_re.astype(f32))
         - jnp.einsum('blgp,ghp->blgh', s_im, c_im.astype(f32)))
    y = y + uf * d_skip.astype(f32).reshape(SSM_GROUPS, SSM_GROUP_WIDTH)
    y = y.reshape(bsz, seq, SSM_CH)
    return (jax.nn.gelu(y) * jax.nn.sigmoid(gate.astype(f32))).astype(dtype)


def hier_moe(h, rg_w, rg_b, re_w, re_b, w_gate, w_up, w_down):
    bsz, seq, d = h.shape
    f32 = jnp.float32
    t = h.reshape(bsz * seq, d)
    g_logits = (t @ rg_w + rg_b).astype(f32)
    g_prob = jax.nn.softmax(g_logits, axis=-1)
    g_idx = jnp.argmax(g_logits, axis=-1)
    g_w = jnp.take_along_axis(g_prob, g_idx[:, None], axis=-1)
    e_logits = (jnp.einsum('td,gde->tge', t, re_w) + re_b).astype(f32)
    e_sel = jnp.take_along_axis(e_logits, g_idx[:, None, None], axis=1)[:, 0]
    top_v, top_i = lax.top_k(e_sel, TOP_K)
    top_w = jax.nn.softmax(top_v, axis=-1) * g_w
    e_w = jnp.sum(jax.nn.one_hot(top_i, EXPERTS_PER_GROUP, dtype=f32) * top_w[..., None], axis=1)
    comb = (jax.nn.one_hot(g_idx, N_GROUPS, dtype=f32)[:, :, None] * e_w[:, None, :]).astype(t.dtype)
    y = jnp.zeros_like(t)
    for g in range(N_GROUPS):
        a = jnp.einsum('td,edf->tef', t, w_gate[g])
        u = jnp.einsum('td,edf->tef', t, w_up[g])
        hm = jax.nn.silu(a) * u * comb[:, g, :, None]
        y = y + jnp.einsum('tef,efd->td', hm, w_down[g])
    return y.reshape(bsz, seq, d)


def setup_inputs(seed: int = 0) -> dict:
    key = jax.random.key(seed)
    ks = jax.random.split(key, 32)
    f32 = jnp.float32
    L, D = DEPTH, D_MODEL
    nrm = lambda k, shape, s: jax.random.normal(k, shape, f32) * s
    gain = lambda k, shape: 1.0 + 0.02 * jax.random.normal(k, shape, f32)
    n_idx = jnp.arange(SSM_STATE, dtype=f32)
    a_re = -0.5 + 0.01 * jax.random.normal(ks[10], (L, SSM_GROUPS, SSM_STATE), f32)
    a_im = math.pi * n_idx + 0.01 * jax.random.normal(ks[11], (L, SSM_GROUPS, SSM_STATE), f32)
    log_dt = jax.random.uniform(ks[18], (L, SSM_GROUPS), f32, math.log(1e-3), math.log(1e-1))
    return {
        'x': jax.random.normal(ks[0], (BATCH, SEQ, D), f32),
        'c': jax.random.normal(ks[1], (BATCH, D), f32),
        'w_ada': nrm(ks[2], (L, D, 6 * D), 0.5 * D ** -0.5),
        'b_ada': nrm(ks[3], (L, 6 * D), 0.02),
        'norm1_g': gain(ks[4], (L, D)),
        'w_in': nrm(ks[5], (L, D, IN_COLS), D ** -0.5),
        'conv_w': nrm(ks[6], (L, CONV_WIDTH, CONV_CH), CONV_WIDTH ** -0.5),
        'conv_b': nrm(ks[7], (L, CONV_CH), 0.02),
        'conv_ln_g': gain(ks[8], (L, CONV_CH)),
        'conv_ln_b': nrm(ks[9], (L, CONV_CH), 0.02),
        'ssm_a_re': a_re,
        'ssm_a_im': a_im,
        'ssm_b_re': nrm(ks[12], (L, SSM_GROUPS, SSM_STATE, SSM_GROUP_WIDTH), (2 * SSM_GROUP_WIDTH) ** -0.5),
        'ssm_b_im': nrm(ks[13], (L, SSM_GROUPS, SSM_STATE, SSM_GROUP_WIDTH), (2 * SSM_GROUP_WIDTH) ** -0.5),
        'ssm_c_re': nrm(ks[14], (L, SSM_GROUPS, SSM_GROUP_WIDTH, SSM_STATE), (2 * SSM_STATE) ** -0.5),
        'ssm_c_im': nrm(ks[15], (L, SSM_GROUPS, SSM_GROUP_WIDTH, SSM_STATE), (2 * SSM_STATE) ** -0.5),
        'ssm_d': nrm(ks[16], (L, SSM_CH), 1.0),
        'ssm_log_dt': log_dt,
        'out_norm_conv_g': gain(ks[17], (L, CONV_CH)),
        'out_norm_ssm_g': gain(ks[19], (L, SSM_CH)),
        'w_out': nrm(ks[20], (L, MIX_WIDTH, D), MIX_WIDTH ** -0.5),
        'norm2_g': gain(ks[21], (L, D)),
        'router_group_w': nrm(ks[22], (L, D, N_GROUPS), D ** -0.5),
        'router_group_b': nrm(ks[23], (L, N_GROUPS), 0.01),
        'router_expert_w': nrm(ks[24], (L, N_GROUPS, D, EXPERTS_PER_GROUP), D ** -0.5),
        'router_expert_b': nrm(ks[25], (L, N_GROUPS, EXPERTS_PER_GROUP), 0.01),
        'exp_w_gate': nrm(ks[26], (L, N_GROUPS, EXPERTS_PER_GROUP, D, D_EXPERT), D ** -0.5),
        'exp_w_up': nrm(ks[27], (L, N_GROUPS, EXPERTS_PER_GROUP, D, D_EXPERT), D ** -0.5),
        'exp_w_down': nrm(ks[28], (L, N_GROUPS, EXPERTS_PER_GROUP, D_EXPERT, D), D_EXPERT ** -0.5),
        'final_norm_g': gain(ks[29], (D,)),
    }


def reference(x, c, w_ada, b_ada, norm1_g, w_in, conv_w, conv_b, conv_ln_g, conv_ln_b,
              ssm_a_re, ssm_a_im, ssm_b_re, ssm_b_im, ssm_c_re, ssm_c_im, ssm_d, ssm_log_dt,
              out_norm_conv_g, out_norm_ssm_g, w_out, norm2_g,
              router_group_w, router_group_b, router_expert_w, router_expert_b,
              exp_w_gate, exp_w_up, exp_w_down, final_norm_g):
    c_act = jax.nn.silu(c)
    for l in range(DEPTH):
        mod = c_act @ w_ada[l] + b_ada[l]
        shift1, scale1, gate1, shift2, scale2, gate2 = jnp.split(mod, 6, axis=-1)

        h = modulate(rms_norm(x, norm1_g[l]), shift1, scale1)
        p = h @ w_in[l]
        o = 0
        conv_val = p[..., o:o + CONV_CH]; o += CONV_CH
        conv_gate = p[..., o:o + CONV_CH]; o += CONV_CH
        ssm_in = p[..., o:o + SSM_CH]; o += SSM_CH
        ssm_gate = p[..., o:o + SSM_CH]
        y_conv = conformer_conv(conv_val, conv_gate, conv_w[l], conv_b[l], conv_ln_g[l], conv_ln_b[l])
        y_ssm = s5_ssm(ssm_in, ssm_gate, ssm_a_re[l], ssm_a_im[l], ssm_b_re[l], ssm_b_im[l],
                       ssm_c_re[l], ssm_c_im[l], ssm_d[l], ssm_log_dt[l])
        y = jnp.concatenate([rms_norm(y_conv, out_norm_conv_g[l]),
                             rms_norm(y_ssm, out_norm_ssm_g[l])], axis=-1) @ w_out[l]
        x = x + gate1[:, None, :] * y

        h = modulate(rms_norm(x, norm2_g[l]), shift2, scale2)
        y = hier_moe(h, router_group_w[l], router_group_b[l], router_expert_w[l], router_expert_b[l],
                     exp_w_gate[l], exp_w_up[l], exp_w_down[l])
        x = x + gate2[:, None, :] * y
    return rms_norm(x, final_norm_g)
```

```cpp
#include <hip/hip_runtime.h>
#include <cstdio>
#include <cstdint>

constexpr int NB = 8, SEQ = 2048, D = 2048, T = NB * SEQ, NL = 2;
constexpr int CCH = 1024, SCH = 1024, CW = 31, NG = 64, GW = 16, NP = 64, INC = 4096;
constexpr int NE = 32, EPG = 8, NGR = 4, FF = 512;
constexpr float EPS = 1e-6f;

typedef unsigned short bf16;
typedef float f32x4 __attribute__((ext_vector_type(4)));
__device__ __forceinline__ float bf2f(bf16 v) { return __uint_as_float(((unsigned)v) << 16); }
__device__ __forceinline__ bf16 f2bf(float f) { unsigned u = __float_as_uint(f); return (bf16)((u + 0x7fffu + ((u >> 16) & 1u)) >> 16); }
__device__ __forceinline__ float sigmoidf_(float x) { return __builtin_amdgcn_rcpf(1.f + __expf(-x)); }
__device__ __forceinline__ float siluf_(float x) { return x * sigmoidf_(x); }
__device__ __forceinline__ float gelu_tanh(float y) { const float u = 1.5957691216057308f * (y + 0.044715f * y * y * y); return y * sigmoidf_(u); }

constexpr size_t MiB = 1u << 20;
constexpr size_t WS_CTL = 0, CTL_BYTES = 1 * MiB;
constexpr size_t WS_MOD = 1 * MiB;
constexpr size_t WS_SSMM = 2 * MiB;
constexpr size_t WS_A16 = 34 * MiB;
constexpr size_t WS_TOKE = 35 * MiB;
constexpr size_t WS_TOKW = 35 * MiB + 512 * 1024;
constexpr size_t WS_LIST = 36 * MiB;
constexpr size_t WS_SSQ = 38 * MiB;
constexpr size_t WS_RW = 42 * MiB;
constexpr size_t WS_WIN = 48 * MiB, WS_WOUT = 80 * MiB, WS_GU = 96 * MiB, WS_DN = 352 * MiB;
constexpr size_t WS_XA = 480 * MiB, WS_XB = 608 * MiB, WS_H = 736 * MiB;
constexpr size_t WS_Z = 800 * MiB, WS_U = 832 * MiB, WS_SG = 864 * MiB, WS_AO = 896 * MiB, WS_HM = 960 * MiB;
constexpr size_t WS_Y = 800 * MiB;
constexpr size_t WS_TMP = 1000 * MiB;
constexpr size_t WS_END = 1064 * MiB;
constexpr int CW_CNT = 1024;
constexpr int HM_ROWS = 2 * T + NE * 256;

struct Ptrs {
    const float *x, *c, *w_ada, *b_ada, *norm1_g, *w_in, *conv_w, *conv_b, *conv_ln_g, *conv_ln_b;
    const float *a_re, *a_im, *b_re, *b_im, *c_re, *c_im, *ssm_d, *log_dt, *onc_g, *ons_g, *w_out, *norm2_g;
    const float *rg_w, *rg_b, *re_w, *re_b, *w_gate, *w_up, *w_down, *final_g;
    float* out; unsigned char* ws;
};

#ifndef PROBE_DUP
#define PROBE_DUP -1
#endif
__device__ __forceinline__ unsigned* ctl_words();
namespace pg8 {
#define PG8_LAS __attribute__((address_space(3)))
typedef unsigned short bf16_t;
typedef short bf16x8 __attribute__((ext_vector_type(8)));
typedef float f32x4 __attribute__((ext_vector_type(4)));
typedef unsigned u32x4 __attribute__((ext_vector_type(4)));
constexpr int BM = 256, BK = 64, HALF = 128, HTB = HALF * BK * 2, STAGE_BYTES = 8 * HTB, NXCD = 8, WGM = 4;

__host__ __device__ __forceinline__ int lds_byte(int r, int c) { const int st = (r >> 4) * 2 + (c >> 5), rr = r & 15, cc = c & 31, ob = rr * 64 + cc * 2; return st * 1024 + (ob ^ (((ob >> 9) & 1) << 5)); }
__host__ __device__ __forceinline__ void stage_rc(int b, int& R, int& C) { const int st = b / 1024, sb = b % 1024, swz = sb ^ (((sb >> 9) & 1) << 5); R = (st >> 1) * 16 + swz / 64; C = (st & 1) * 32 + (swz % 64) / 2; }
__host__ __device__ __forceinline__ int perm32(int rho) { const int n = rho >> 4, i = rho & 15; return 8 * (i >> 2) + 4 * n + (i & 3); }

struct Unit { int pm, pn, e, mloc; };
struct Gemm { const bf16_t* A; const bf16_t* Bt; int M, N, K; };

struct StaticOrder {
    int nM, nN, nwg, G, c;
    __device__ void init(int M, int N, int G_, int c_) { nM = M / BM; nN = N / BM; nwg = nM * nN; G = G_; c = c_; }
    __device__ bool next(int i, Unit& u) const {
        const long L = (long)i * G + c; if (L >= nwg) return false;
        int wgid = (int)L; { const int q = nwg / NXCD, r = nwg % NXCD, xcd = wgid % NXCD, off = wgid / NXCD; wgid = (xcd < r ? xcd * (q + 1) : r * (q + 1) + (xcd - r) * q) + off; }
        const int nig = WGM * nN, gid = wgid / nig, fm = gid * WGM, gsz = (nM - fm) < WGM ? (nM - fm) : WGM;
        u.pm = fm + ((wgid % nig) % gsz); u.pn = (wgid % nig) / gsz; u.e = 0; u.mloc = 0; return true;
    }
};
struct MoeOrder {
    const PG8_LAS int* ptile; int npn, G, c, total, rep;
    __device__ __forceinline__ void decode(int j, Unit& u) const {
        const int mt = j / npn, pn = j % npn;
        int ln_ = (int)__builtin_amdgcn_mbcnt_hi(~0u, __builtin_amdgcn_mbcnt_lo(~0u, 0u)); asm volatile("" : "+v"(ln_));
        const int pv = ptile[(ln_ & 31) + 1];
        const int e = __builtin_popcountll(__ballot(pv <= mt) & 0xffffffffull);
        u.pm = mt; u.pn = e * npn + pn; u.e = e; u.mloc = __builtin_amdgcn_readfirstlane(mt - ptile[e]);
    }
    __device__ bool next(int i, Unit& u) const {
        long L = (long)i * G + c; if (L >= (long)total * rep) return false;
        if (L >= total) L -= total;
        decode((int)L, u); return true;
    }
};
struct MoeOrder2 {
    const PG8_LAS int* ptile; int npn, G, c, total, r, pre, part;
    __device__ bool next(int i, Unit& u) const {
        const int preN = pre * (G - r); int j;
        if (part == 0) { if (c < r || i >= pre) return false; j = i * (G - r) + (c - r); }
        else j = preN + i * G + c;
        if (j >= total) return false;
        MoeOrder o{ptile, npn, G, c, total, 1}; o.decode(j, u); return true;
    }
};

__device__ __forceinline__ unsigned cvt_pk_bf16(float lo, float hi) { unsigned r; asm volatile("v_cvt_pk_bf16_f32 %0, %1, %2" : "=v"(r) : "v"(lo), "v"(hi)); return r; }

template <class Epi, class Sched, bool GATHER, int KC>
__device__ __forceinline__ void gemm_phase(PG8_LAS unsigned char* lds, const Gemm g, const Sched& S, const Epi& E, const PG8_LAS int* rowtab, const int wv) {
    int tid_ = wv * 64 + (int)__builtin_amdgcn_mbcnt_hi(~0u, __builtin_amdgcn_mbcnt_lo(~0u, 0u)); asm volatile("" : "+v"(tid_));
    const int tid = tid_, wid = wv, lane = tid & 63, wr = wid >> 2, wc = wid & 3, fr = lane & 15, fq = lane >> 4;
    constexpr int K = KC, nt = K / BK;
    unsigned voffA[2], voffB[2]; int Rr[2];
#pragma unroll
    for (int i = 0; i < 2; ++i) { int R, C; stage_rc(tid * 16 + i * 8192, R, C); const int Rb = Epi::PERM ? ((R & ~31) + perm32(R & 31)) : R;
        voffA[i] = GATHER ? (unsigned)(C * 2) : (unsigned)(R * K + C) * 2u; voffB[i] = (unsigned)(Rb * K + C) * 2u; Rr[i] = R; }
    constexpr size_t kstep = (size_t)(BK * 2);
    constexpr size_t hstep = (size_t)HALF * K * 2;
    constexpr size_t tstep = 2 * hstep;
    const unsigned ldsw = (unsigned)wid * 1024u;
    const int aoff = lds_byte(wr * 64 + fr, fq * 8), boff = lds_byte(wc * 32 + fr, fq * 8);
#define PG8_SA(b, h) (((b) * 2 + (h)) * HTB)
#define PG8_SB(b, h) ((4 + (b) * 2 + (h)) * HTB)
#define PG8_STAGE(bufoff, gbase, voff) do { _Pragma("unroll") for (int _i = 0; _i < 2; ++_i) \
        __builtin_amdgcn_global_load_lds((const unsigned*)((const char*)(gbase) + (voff)[_i]), (PG8_LAS unsigned*)(lds + (bufoff) + ldsw + _i * 8192), 16, 0, 0); } while (0)
#define PG8_STA(bufoff, usel, h, kb) do { if constexpr (GATHER) { unsigned _o[2]; _o[0] = (usel) ? gan[h][0] : gac[h][0]; _o[1] = (usel) ? gan[h][1] : gac[h][1]; PG8_STAGE(bufoff, gA + (kb), _o); } \
        else { PG8_STAGE(bufoff, ((usel) ? nA : cA) + (h) * hstep + (kb), voffA); } } while (0)
#define PG8_LDA(dst, b, h) do { _Pragma("unroll") for (int m = 0; m < 4; ++m) _Pragma("unroll") for (int k = 0; k < 2; ++k) dst[m][k] = *(const PG8_LAS bf16x8*)(lds + PG8_SA(b, h) + aoff + m * 2048 + k * 1024); } while (0)
#define PG8_LDB(dst, b, h) do { _Pragma("unroll") for (int n = 0; n < 2; ++n) _Pragma("unroll") for (int k = 0; k < 2; ++k) dst[n][k] = *(const PG8_LAS bf16x8*)(lds + PG8_SB(b, h) + boff + n * 2048 + k * 1024); } while (0)
#define PG8_MMA(ai, bj, At, Bt) do { __builtin_amdgcn_s_setprio(1); _Pragma("unroll") for (int m = 0; m < 4; ++m) _Pragma("unroll") for (int n = 0; n < 2; ++n) _Pragma("unroll") for (int k = 0; k < 2; ++k) \
        acc[ai][bj][m][n] = __builtin_amdgcn_mfma_f32_16x16x32_bf16(Bt[n][k], At[m][k], acc[ai][bj][m][n], 0, 0, 0); __builtin_amdgcn_s_setprio(0); } while (0)
#define PG8_WAIT_V(n) asm volatile("s_waitcnt vmcnt(" #n ")" ::: "memory")
#define PG8_WAIT_L(n) asm volatile("s_waitcnt lgkmcnt(" #n ")" ::: "memory")
#define PG8_BAR __builtin_amdgcn_s_barrier()
#define PG8_SCHED __builtin_amdgcn_sched_barrier(0)
#define PG8_GROWS(dst, slot) do { _Pragma("unroll") for (int _h = 0; _h < 2; ++_h) _Pragma("unroll") for (int _i = 0; _i < 2; ++_i) \
        dst[_h][_i] = (unsigned)rowtab[(slot) * 256 + _h * 128 + Rr[_i]] * (unsigned)(K * 2) + voffA[_i]; } while (0)
    Unit cur, nxt; int ui = 0;
    if (!S.next(0, cur)) return;
    f32x4 acc[2][2][4][2];
#pragma unroll
    for (int a = 0; a < 2; ++a)
#pragma unroll
        for (int b = 0; b < 2; ++b)
#pragma unroll
            for (int m = 0; m < 4; ++m)
#pragma unroll
                for (int n = 0; n < 2; ++n) acc[a][b][m][n] = (f32x4){0.f, 0.f, 0.f, 0.f};
    bf16x8 At[4][2], B0[2][2], B1[2][2];
    const char* const gA = (const char*)g.A;
    const char* cA = gA + (size_t)cur.pm * tstep; const char* cB = (const char*)g.Bt + (size_t)cur.pn * tstep;
    const char* nA = cA;
    unsigned gac[2][2], gan[2][2];
    if constexpr (GATHER) { PG8_GROWS(gac, 0); } else { gac[0][0] = gac[0][1] = gac[1][0] = gac[1][1] = 0u; }
#pragma unroll
    for (int h = 0; h < 2; ++h) { gan[h][0] = gac[h][0]; gan[h][1] = gac[h][1]; }
    PG8_STAGE(PG8_SB(0, 0), cB, voffB); PG8_STAGE(PG8_SB(0, 1), cB + hstep, voffB); PG8_STA(PG8_SA(0, 0), 0, 0, (size_t)0); PG8_STA(PG8_SA(0, 1), 0, 1, (size_t)0);
    if (wr == 1) PG8_BAR;
    PG8_WAIT_V(2); PG8_BAR;
    PG8_STAGE(PG8_SB(1, 0), cB + kstep, voffB); PG8_STA(PG8_SA(1, 0), 0, 0, kstep); PG8_STAGE(PG8_SB(1, 1), cB + hstep + kstep, voffB);
    PG8_WAIT_V(6); PG8_BAR;
    for (;;) {
        const bool has_next = S.next(ui + 1, nxt);
        nA = has_next ? gA + (size_t)nxt.pm * tstep : cA; const char* nB = has_next ? (const char*)g.Bt + (size_t)nxt.pn * tstep : cB;
        if constexpr (GATHER) { if (has_next) { PG8_GROWS(gan, ui + 1); } }
        for (int t = 0; t < nt; t += 2) {
            const bool last = (t == nt - 2);
            const size_t kb1 = (size_t)(t + 1) * kstep;
            const size_t kb2 = last ? (size_t)0 : (size_t)(t + 2) * kstep;
            const char* b2 = last ? nB : cB + (size_t)(t + 2) * kstep;
            const char* b3 = b2 + kstep;
            if constexpr (Epi::MIDSCALE) { if (t == nt / 2) E.midscale(acc, ui, wr, fr); }
            PG8_LDB(B0, 0, 0); PG8_LDB(B1, 0, 1); PG8_SCHED; PG8_LDA(At, 0, 0); PG8_STA(PG8_SA(1, 1), 0, 1, kb1);
            PG8_WAIT_V(8); PG8_WAIT_L(0); PG8_BAR; PG8_MMA(0, 0, At, B0); PG8_MMA(0, 1, At, B1); PG8_BAR; PG8_SCHED;
            PG8_LDA(At, 0, 1); PG8_STAGE(PG8_SB(0, 0), b2, voffB); PG8_STAGE(PG8_SB(0, 1), b2 + hstep, voffB); PG8_STA(PG8_SA(0, 0), last, 0, kb2);
            PG8_WAIT_V(8); PG8_WAIT_L(0); PG8_BAR; PG8_MMA(1, 0, At, B0); PG8_MMA(1, 1, At, B1); PG8_BAR; PG8_SCHED;
            PG8_LDB(B0, 1, 0); PG8_LDB(B1, 1, 1); PG8_SCHED; PG8_LDA(At, 1, 0); PG8_STA(PG8_SA(0, 1), last, 1, kb2);
            PG8_WAIT_V(8); PG8_WAIT_L(0); PG8_BAR; PG8_MMA(0, 0, At, B0); PG8_MMA(0, 1, At, B1); PG8_BAR; PG8_SCHED;
            PG8_LDA(At, 1, 1); PG8_STAGE(PG8_SB(1, 0), b3, voffB); PG8_STAGE(PG8_SB(1, 1), b3 + hstep, voffB); PG8_STA(PG8_SA(1, 0), last, 0, kb2 + kstep);
            PG8_WAIT_V(8); PG8_WAIT_L(0); PG8_BAR; PG8_MMA(1, 0, At, B0); PG8_MMA(1, 1, At, B1); PG8_BAR; PG8_SCHED;
        }
        if (wr == 0) PG8_BAR;
        E(acc, cur, ui, wr, wc, fr, fq);
        if (!has_next) break;
#pragma unroll
        for (int a = 0; a < 2; ++a)
#pragma unroll
            for (int b = 0; b < 2; ++b)
#pragma unroll
                for (int m = 0; m < 4; ++m)
#pragma unroll
                    for (int n = 0; n < 2; ++n) acc[a][b][m][n] = (f32x4){0.f, 0.f, 0.f, 0.f};
        cur = nxt; cA = nA; cB = nB; ++ui;
#pragma unroll
        for (int h = 0; h < 2; ++h) { gac[h][0] = gan[h][0]; gac[h][1] = gan[h][1]; }
        if (wr == 1) PG8_BAR;
    }
    PG8_WAIT_V(0);
    PG8_BAR;
#undef PG8_SA
#undef PG8_SB
#undef PG8_STAGE
#undef PG8_STA
#undef PG8_LDA
#undef PG8_LDB
#undef PG8_MMA
#undef PG8_WAIT_V
#undef PG8_WAIT_L
#undef PG8_BAR
#undef PG8_SCHED
#undef PG8_GROWS
}
}

constexpr int NWAVES = 8, NTHR = NWAVES * 64;
constexpr int SCR_BYTES = 148480;
constexpr int LCTL_OFF = SCR_BYTES;
constexpr int L_MISC = LCTL_OFF;
constexpr int L_PTILE = LCTL_OFF + 128;
constexpr int L_CNT = LCTL_OFF + 320;
constexpr int L_TAB = LCTL_OFF + 512;
constexpr int LDS_BYTES = 163840;
static_assert(L_TAB + 14336 <= LDS_BYTES, "LDS map");

#define GAS __attribute__((address_space(1)))
#define LAS __attribute__((address_space(3)))
typedef float f32x2v __attribute__((ext_vector_type(2)));
typedef unsigned v4u __attribute__((ext_vector_type(4)));
typedef unsigned v2u __attribute__((ext_vector_type(2)));
typedef short bf16x8 __attribute__((ext_vector_type(8)));
typedef _Float16 f16x8 __attribute__((ext_vector_type(8)));
typedef _Float16 f16x2 __attribute__((ext_vector_type(2)));
#define LDS_WAIT() asm volatile("s_waitcnt lgkmcnt(0)" ::: "memory")
#define VM_WAIT() asm volatile("s_waitcnt vmcnt(0)" ::: "memory")
typedef __bf16 bf16x2_hw __attribute__((ext_vector_type(2)));
__device__ __forceinline__ unsigned pk2(float lo, float hi) { const f32x2v v = {lo, hi}; const bf16x2_hw b = __builtin_convertvector(v, bf16x2_hw); return __builtin_bit_cast(unsigned, b); }
__device__ __forceinline__ float dpp_add(float v, const int ctrl_sel) {
    int x = __builtin_bit_cast(int, v), y;
    if (ctrl_sel == 0) y = __builtin_amdgcn_update_dpp(0, x, 0xB1, 0xf, 0xf, true);
    else if (ctrl_sel == 1) y = __builtin_amdgcn_update_dpp(0, x, 0x4E, 0xf, 0xf, true);
    else if (ctrl_sel == 2) y = __builtin_amdgcn_update_dpp(0, x, 0x141, 0xf, 0xf, true);
    else y = __builtin_amdgcn_update_dpp(0, x, 0x140, 0xf, 0xf, true);
    return v + __builtin_bit_cast(float, y);
}
__device__ __forceinline__ float row16_sum(float v) { v = dpp_add(v, 0); v = dpp_add(v, 1); v = dpp_add(v, 2); v = dpp_add(v, 3); return v; }
__device__ __forceinline__ float wave_sum(float v) {
    v = row16_sum(v);
    const int x = __builtin_bit_cast(int, v);
    const float r0 = __builtin_bit_cast(float, __builtin_amdgcn_readlane(x, 0)), r1 = __builtin_bit_cast(float, __builtin_amdgcn_readlane(x, 16));
    const float r2 = __builtin_bit_cast(float, __builtin_amdgcn_readlane(x, 32)), r3 = __builtin_bit_cast(float, __builtin_amdgcn_readlane(x, 48));
    return (r0 + r1) + (r2 + r3);
}
__device__ __forceinline__ float shfl_xor_fresh(float v, int mask) {
    int l = __builtin_amdgcn_mbcnt_hi(~0u, __builtin_amdgcn_mbcnt_lo(~0u, 0u)); asm volatile("" : "+v"(l));
    return __builtin_bit_cast(float, __builtin_amdgcn_ds_bpermute((l ^ mask) << 2, __builtin_bit_cast(int, v)));
}

#define XB_TMO      128
#define XB_XCNT(j)  (256  + 64 * (j))
#define XB_XSUB(j)  (1280 + 64 * (j))
#define XB_XGEN(j)  (2304 + 64 * (j))
#define XB_TOP      3328
#define XB_TOPGEN   3392
#define XCD_BAR_WORDS 3456
#define XB_SPIN_CAP (1u << 18)
__device__ __forceinline__ unsigned xb_ld(unsigned* p)              { return __hip_atomic_load(p, __ATOMIC_RELAXED, __HIP_MEMORY_SCOPE_AGENT); }
__device__ __forceinline__ unsigned xb_add(unsigned* p, unsigned v) { return __hip_atomic_fetch_add(p, v, __ATOMIC_RELAXED, __HIP_MEMORY_SCOPE_AGENT); }
__device__ __forceinline__ unsigned xb_xcc_id() { return (unsigned)__builtin_amdgcn_s_getreg((3 << 11) | 20) & 0xFu; }
#define XB_SPIN(cond, bar) do { unsigned _sp = 0; while (cond) { __builtin_amdgcn_s_sleep(1); \
    if ((++_sp & 255u) == 0u) { if (xb_ld(&(bar)[XB_TMO])) break; if (_sp > XB_SPIN_CAP) { atomicAdd(&(bar)[XB_TMO], 1u); break; } } } } while (0)
struct XcdBarrier { unsigned* bar; unsigned x; volatile LAS unsigned* st; int wv; };
__device__ __forceinline__ bool xb_thread0(int wv) { return wv == 0 && __builtin_amdgcn_mbcnt_hi(~0u, __builtin_amdgcn_mbcnt_lo(~0u, 0u)) == 0u; }
__device__ __forceinline__ XcdBarrier xcd_barrier_post(unsigned* bar, volatile LAS unsigned* st, int wv) {
    XcdBarrier b; b.bar = bar; b.x = xb_xcc_id(); b.st = st; b.wv = wv;
    if (xb_thread0(wv)) (void)xb_add(&bar[XB_XCNT(b.x)], 1u);
    return b;
}
__device__ __forceinline__ void xcd_barrier_complete(unsigned* bar, unsigned x, unsigned& nloc, unsigned& nx) {
    const unsigned G = gridDim.x * gridDim.y * gridDim.z;
    unsigned sum, cnt, mine, sp = 0u;
    for (;;) {
        sum = 0u; cnt = 0u; mine = 0u;
#pragma unroll
        for (unsigned j = 0; j < 16; ++j) { const unsigned c = xb_ld(&bar[XB_XCNT(j)]); sum += c; cnt += (c > 0u) ? 1u : 0u; mine = (j == x) ? c : mine; }
        if (sum == G) break;
        __builtin_amdgcn_s_sleep(1);
        if ((++sp & 255u) == 0u) { if (xb_ld(&bar[XB_TMO])) break; if (sp > XB_SPIN_CAP) { atomicAdd(&bar[XB_TMO], 1u); break; } }
    }
    nloc = mine > 0u ? mine : 1u; nx = cnt > 0u ? cnt : 1u;
}
__device__ __forceinline__ void xcd_barrier(const XcdBarrier& b) {
    asm volatile("s_waitcnt vmcnt(0)" ::: "memory");
    __syncthreads();
    if (xb_thread0(b.wv)) {
        unsigned* bar = b.bar;
        __builtin_amdgcn_s_waitcnt(0);
        unsigned nloc = b.st[0], nx = b.st[1];
        if (nloc == 0u) { xcd_barrier_complete(bar, b.x, nloc, nx); b.st[0] = nloc; b.st[1] = nx; }
        const unsigned old = xb_add(&bar[XB_XSUB(b.x)], 1u);
        const unsigned gen = old / nloc;
        if (old + 1u == (gen + 1u) * nloc) {
            __builtin_amdgcn_fence(__ATOMIC_RELEASE, "agent");
            asm volatile("s_waitcnt vmcnt(0)" ::: "memory");
            const unsigned og = xb_add(&bar[XB_TOP], 1u);
            const unsigned tg = og / nx;
            if (og + 1u == (tg + 1u) * nx) xb_add(&bar[XB_TOPGEN], 1u);
            else XB_SPIN(xb_ld(&bar[XB_TOPGEN]) == tg, bar);
            __builtin_amdgcn_fence(__ATOMIC_ACQUIRE, "agent");
            xb_add(&bar[XB_XGEN(b.x)], 1u);
            asm volatile("s_waitcnt vmcnt(0)" ::: "memory");
        } else {
            XB_SPIN(xb_ld(&bar[XB_XGEN(b.x)]) == gen, bar);
            __builtin_amdgcn_fence(__ATOMIC_ACQUIRE, "agent");
            asm volatile("s_waitcnt vmcnt(0)" ::: "memory");
        }
    }
    __syncthreads();
}
constexpr int CW_HMC = 32768, CW_TMO = 2048;   static_assert(CW_TMO == 2048, "MoeOrder2 uses the literal");
#ifndef MOE2_PRE
#define MOE2_PRE 4
#endif
constexpr int CW_BAR = 4096;
static_assert((CW_BAR + XCD_BAR_WORDS) * 4 <= (int)CTL_BYTES, "ctl words");

using pg8::f32x4; using pg8::Unit;
struct EpiIn {
    static constexpr bool PERM = true, MIDSCALE = false;
    bf16* Z; bf16* U; bf16* SG;
    __device__ __forceinline__ void operator()(const f32x4 (&acc)[2][2][4][2], const Unit& u, int, int wr, int wc, int fr, int fq) const {
        const int row0 = u.pm * 256 + wr * 64 + fr, cb = (u.pn & 7) * 128 + wc * 32 + 8 * fq;
#pragma unroll
        for (int ai = 0; ai < 2; ++ai)
#pragma unroll
            for (int m = 0; m < 4; ++m) {
                const int row = row0 + ai * 128 + m * 16;
                float v[8], s[8];
#pragma unroll
                for (int n = 0; n < 2; ++n)
#pragma unroll
                    for (int j = 0; j < 4; ++j) { v[n * 4 + j] = acc[ai][0][m][n][j]; s[n * 4 + j] = sigmoidf_(acc[ai][1][m][n][j]); }
                if (u.pn < 8) {
                    v4u w; w.x = pk2(v[0] * s[0], v[1] * s[1]); w.y = pk2(v[2] * s[2], v[3] * s[3]); w.z = pk2(v[4] * s[4], v[5] * s[5]); w.w = pk2(v[6] * s[6], v[7] * s[7]);
                    *(v4u*)(Z + (size_t)row * CCH + cb) = w;
                } else {
                    const int b = row >> 11, t = row & (SEQ - 1), g = cb >> 4, h0 = cb & 15;
                    const size_t o = (((size_t)b * NG + g) * SEQ + t) * GW + h0;
                    v4u w; w.x = pk2(v[0], v[1]); w.y = pk2(v[2], v[3]); w.z = pk2(v[4], v[5]); w.w = pk2(v[6], v[7]);
                    v4u q; q.x = pk2(s[0], s[1]); q.y = pk2(s[2], s[3]); q.z = pk2(s[4], s[5]); q.w = pk2(s[6], s[7]);
                    *(v4u*)(U + o) = w; *(v4u*)(SG + o) = q;
                }
            }
    }
};
struct EpiOut {
    static constexpr bool PERM = true, MIDSCALE = true;
    bf16* xb; const float* gate1;
    const LAS float* rs;
    __device__ __forceinline__ void midscale(f32x4 (&acc)[2][2][4][2], int ui, int wr, int fr) const {
#pragma unroll
        for (int ai = 0; ai < 2; ++ai)
#pragma unroll
            for (int m = 0; m < 4; ++m) { const float r = rs[ui * 256 + ai * 128 + wr * 64 + m * 16 + fr];
#pragma unroll
                for (int bj = 0; bj < 2; ++bj)
#pragma unroll
                    for (int n = 0; n < 2; ++n) acc[ai][bj][m][n] *= r; }
    }
    __device__ __forceinline__ void operator()(const f32x4 (&acc)[2][2][4][2], const Unit& u, int, int wr, int wc, int fr, int fq) const {
        const int row0 = u.pm * 256 + wr * 64 + fr, col0 = u.pn * 256 + wc * 32 + 8 * fq;
        const float* g1 = gate1 + (size_t)(row0 >> 11) * 6 * D + col0;
        f32x4 gv[2][2];
#pragma unroll
        for (int bj = 0; bj < 2; ++bj)
#pragma unroll
            for (int n = 0; n < 2; ++n) gv[bj][n] = *(const f32x4*)(g1 + bj * 128 + n * 4);
#pragma unroll
        for (int ai = 0; ai < 2; ++ai) {
            v4u xv[4][2];
#pragma unroll
            for (int m = 0; m < 4; ++m) { const bf16* rp = xb + (size_t)(row0 + ai * 128 + m * 16) * D + col0; xv[m][0] = *(const v4u*)rp; xv[m][1] = *(const v4u*)(rp + 128); }
            __builtin_amdgcn_sched_barrier(0);
#pragma unroll
            for (int m = 0; m < 4; ++m) { bf16* rp = xb + (size_t)(row0 + ai * 128 + m * 16) * D + col0;
#pragma unroll
                for (int bj = 0; bj < 2; ++bj) { const f32x4 a0 = gv[bj][0] * acc[ai][bj][m][0], a1 = gv[bj][1] * acc[ai][bj][m][1]; const v4u x = xv[m][bj];
                    v4u o; o.x = pk2(__uint_as_float(x.x << 16) + a0[0], __uint_as_float(x.x & 0xffff0000u) + a0[1]); o.y = pk2(__uint_as_float(x.y << 16) + a0[2], __uint_as_float(x.y & 0xffff0000u) + a0[3]);
                    o.z = pk2(__uint_as_float(x.z << 16) + a1[0], __uint_as_float(x.z & 0xffff0000u) + a1[1]); o.w = pk2(__uint_as_float(x.w << 16) + a1[2], __uint_as_float(x.w & 0xffff0000u) + a1[3]);
                    *(v4u*)(rp + bj * 128) = o; } }
            __builtin_amdgcn_sched_barrier(0);
        }
    }
};
struct EpiMoe1 {
    static constexpr bool PERM = true, MIDSCALE = false;
    bf16* HM; int hoff;
    __device__ __forceinline__ void operator()(const f32x4 (&acc)[2][2][4][2], const Unit& u, int, int wr, int wc, int fr, int fq) const {
        const int row0 = u.pm * 256 + wr * 64 + fr, cb = (u.pn & 3) * 128 + wc * 32 + 8 * fq;
#pragma unroll
        for (int ai = 0; ai < 2; ++ai)
#pragma unroll
            for (int m = 0; m < 4; ++m) {
                float v[8];
#pragma unroll
                for (int n = 0; n < 2; ++n)
#pragma unroll
                    for (int j = 0; j < 4; ++j) v[n * 4 + j] = siluf_(acc[ai][0][m][n][j]) * acc[ai][1][m][n][j];
                v4u w; w.x = pk2(v[0], v[1]); w.y = pk2(v[2], v[3]); w.z = pk2(v[4], v[5]); w.w = pk2(v[6], v[7]);
                bf16* p = HM + (size_t)(row0 + ai * 128 + m * 16) * FF + cb;
                asm volatile("global_store_dwordx4 %0, %1, off sc1\n\ts_nop 3" :: "v"(p), "v"(w) : "memory");
            }
        asm volatile("s_waitcnt vmcnt(0)" ::: "memory");
        if ((fr | fq) == 0) (void)__hip_atomic_fetch_add(ctl_words() + hoff + 64 * u.pm, 1u, __ATOMIC_RELAXED, __HIP_MEMORY_SCOPE_AGENT);
    }
};
struct EpiMoe2 {
    static constexpr bool PERM = true, MIDSCALE = false;
    bf16* Y; const LAS unsigned* ent; const LAS float* wt;
    __device__ __forceinline__ void operator()(const f32x4 (&acc)[2][2][4][2], const Unit& u, int ui, int wr, int wc, int fr, int fq) const {
        const int cb = (u.pn & 7) * 256 + wc * 32 + 8 * fq;
#pragma unroll
        for (int ai = 0; ai < 2; ++ai)
#pragma unroll
            for (int m = 0; m < 4; ++m) {
                const int rl = ui * 256 + ai * 128 + wr * 64 + m * 16 + fr;
                const unsigned en = ent[rl]; const float w = wt[rl];
                if (en != ~0u) {
                    bf16* yr = Y + ((size_t)(en & 1u) * T + (en >> 1)) * D + cb;
#pragma unroll
                    for (int bj = 0; bj < 2; ++bj) { const f32x4 a0 = acc[ai][bj][m][0] * w, a1 = acc[ai][bj][m][1] * w;
                        v4u o; o.x = pk2(a0[0], a0[1]); o.y = pk2(a0[2], a0[3]); o.z = pk2(a1[0], a1[1]); o.w = pk2(a1[2], a1[3]);
                        *(v4u*)(yr + bj * 128) = o; }
                }
            }
    }
};

struct Frame {
    LAS unsigned char* lds;
    int vcu, G, wv;
};
__device__ __forceinline__ int fresh_tid(int wv) { int t = wv * 64 + (int)__builtin_amdgcn_mbcnt_hi(~0u, __builtin_amdgcn_mbcnt_lo(~0u, 0u)); asm volatile("" : "+v"(t)); return t; }
__device__ __forceinline__ int fresh_wave(int wv) { asm volatile("" : "+s"(wv)); return wv; }
#define PHASE_IDS const int wave = fresh_wave(F.wv), tid = fresh_tid(wave), lane = tid & 63; (void)lane
typedef __attribute__((address_space(4))) const Ptrs* KPtr;
__device__ __forceinline__ KPtr kp() { KPtr a = (KPtr)__builtin_amdgcn_kernarg_segment_ptr(); asm volatile("" : "+s"(a)); return a; }
#define KP (kp())
__device__ __forceinline__ unsigned* ctl_words() { return (unsigned*)(KP->ws + WS_CTL); }

struct P0Tile { const float* src; bf16* dst; int ld, K; };
__device__ __forceinline__ void p0_load(const P0Tile& t, f32x4 (&v)[16], int lane) {
    const float* s = t.src + (size_t)(16 * (lane >> 4)) * t.ld + 4 * (lane & 15);
#pragma unroll
    for (int i = 0; i < 16; ++i) v[i] = __builtin_nontemporal_load((const f32x4*)(s + (size_t)i * t.ld));
}
__device__ __forceinline__ void p0_store(const P0Tile& t, const f32x4 (&v)[16], LAS unsigned char* scr, int lane) {
#pragma unroll
    for (int j = 0; j < 4; ++j) {
        v4u a, b2;
        a.x = pk2(v[0][j], v[1][j]); a.y = pk2(v[2][j], v[3][j]); a.z = pk2(v[4][j], v[5][j]); a.w = pk2(v[6][j], v[7][j]);
        b2.x = pk2(v[8][j], v[9][j]); b2.y = pk2(v[10][j], v[11][j]); b2.z = pk2(v[12][j], v[13][j]); b2.w = pk2(v[14][j], v[15][j]);
        LAS unsigned char* r = scr + (4 * (lane & 15) + j) * 144 + 32 * (lane >> 4);
        *(LAS v4u*)r = a; *(LAS v4u*)(r + 16) = b2;
    }
    LDS_WAIT(); asm volatile("" ::: "memory");
#pragma unroll
    for (int q = 0; q < 8; ++q) { const int n = 8 * q + (lane >> 3); const v4u o = *(const LAS v4u*)(scr + n * 144 + 16 * (lane & 7));
        __builtin_nontemporal_store(o, (v4u*)(t.dst + (size_t)n * t.K + 8 * (lane & 7))); }
    LDS_WAIT(); asm volatile("" ::: "memory");
}
constexpr int P0_IT_WIN = NL * (INC / 64) * (D / 64);
constexpr int P0_IT_WOUT = NL * (D / 64) * (D / 64);
constexpr int P0_IT_GU = NL * NE * (2 * FF / 64) * (D / 64);
constexpr int P0_IT_DN = NL * NE * (D / 64) * (FF / 64);
constexpr int P0_ITEMS = P0_IT_WIN + P0_IT_WOUT + P0_IT_GU + P0_IT_DN;
__device__ __forceinline__ void p0_nbkb(int r, int KBt, int& nb, int& kb) { nb = r / KBt; kb = r % KBt; }
__device__ __forceinline__ P0Tile p0_tile_of(int it) {
    unsigned char* ws = KP->ws; P0Tile t; int nb, kb;
    if (it < P0_IT_WIN) {
        const int l = it / (P0_IT_WIN / NL), r = it % (P0_IT_WIN / NL); p0_nbkb(r, D / 64, nb, kb);
        const int n0 = nb * 64, pn = n0 >> 8, w = n0 & 255, half = w >> 7, j = w & 127;
        const int sc = (pn < 8 ? 0 : 2048) + half * 1024 + (pn & 7) * 128 + j;
        t.src = KP->w_in + (size_t)l * D * INC + (size_t)(kb * 64) * INC + sc; t.ld = INC; t.dst = (bf16*)(ws + WS_WIN) + ((size_t)l * INC + n0) * D + kb * 64; t.K = D;
        return t;
    }
    it -= P0_IT_WIN;
    if (it < P0_IT_WOUT) {
        const int l = it / (P0_IT_WOUT / NL), r = it % (P0_IT_WOUT / NL); p0_nbkb(r, D / 64, nb, kb);
        const int k0 = kb * 64, sk = (k0 < SCH) ? k0 + CCH : k0 - SCH;
        t.src = KP->w_out + (size_t)l * D * D + (size_t)sk * D + nb * 64; t.ld = D; t.dst = (bf16*)(ws + WS_WOUT) + ((size_t)l * D + nb * 64) * D + k0; t.K = D;
        return t;
    }
    it -= P0_IT_WOUT;
    if (it < P0_IT_GU) {
        const int le = it / 512, r = it % 512; p0_nbkb(r, D / 64, nb, kb);
        const int n0 = nb * 64, pn = n0 >> 8, w = n0 & 255, half = w >> 7, j = w & 127, f0 = pn * 128 + j;
        t.src = (half ? KP->w_up : KP->w_gate) + (size_t)le * D * FF + (size_t)(kb * 64) * FF + f0; t.ld = FF; t.dst = (bf16*)(ws + WS_GU) + ((size_t)le * 2 * FF + n0) * D + kb * 64; t.K = D;
        return t;
    }
    it -= P0_IT_GU;
    {
        const int le = it / 256, r = it % 256; p0_nbkb(r, FF / 64, nb, kb);
        t.src = KP->w_down + (size_t)le * FF * D + (size_t)(kb * 64) * D + nb * 64; t.ld = D; t.dst = (bf16*)(ws + WS_DN) + ((size_t)le * D + nb * 64) * FF + kb * 64; t.K = FF;
    }
    return t;
}
__device__ __forceinline__ void p0_mod_item(Frame& F, int item) {
    PHASE_IDS;
    const int l = item / 96, cbk = item % 96, col = cbk * 128 + 2 * lane;
    LAS float* ca = (LAS float*)F.lds;
    LAS float* red = (LAS float*)(F.lds + 65536);
    for (int i = tid; i < NB * D; i += NTHR) { const int b = i / D, k = i % D; ca[k * 8 + b] = siluf_(KP->c[i]); }
    __syncthreads();
    float a0[8], a1[8];
#pragma unroll
    for (int b = 0; b < 8; ++b) { a0[b] = 0.f; a1[b] = 0.f; }
    const float* w = KP->w_ada + (size_t)l * D * 6 * D + (size_t)(wave * 256) * 6 * D + col;
#pragma unroll 32
    for (int k = 0; k < 256; ++k) {
        const f32x2v wv_ = __builtin_nontemporal_load((const f32x2v*)(w + (size_t)k * 6 * D)); const float2 wv = {wv_.x, wv_.y};
        const f32x4 c0 = *(const LAS f32x4*)(ca + (wave * 256 + k) * 8), c1 = *(const LAS f32x4*)(ca + (wave * 256 + k) * 8 + 4);
#pragma unroll
        for (int b = 0; b < 4; ++b) { a0[b] += c0[b] * wv.x; a1[b] += c0[b] * wv.y; a0[4 + b] += c1[b] * wv.x; a1[4 + b] += c1[b] * wv.y; }
    }
#pragma unroll
    for (int b = 0; b < 8; ++b) { red[(wave * 8 + b) * 128 + 2 * lane] = a0[b]; red[(wave * 8 + b) * 128 + 2 * lane + 1] = a1[b]; }
    __syncthreads();
    for (int o = tid; o < 8 * 128; o += NTHR) { const int b = o >> 7, cc = o & 127; float s = KP->b_ada[l * 6 * D + cbk * 128 + cc];
#pragma unroll
        for (int wv = 0; wv < 8; ++wv) s += red[(wv * 8 + b) * 128 + cc];
        ((float*)(KP->ws + WS_MOD))[((size_t)l * NB + b) * 6 * D + cbk * 128 + cc] = s; }
    __syncthreads();
}
constexpr int RW_FRAGS = NL * 64 * 3;
__device__ __forceinline__ void p0_router_frag(Frame& F, int fi, int lane);
__device__ __forceinline__ void p0_ssm_mats(Frame& F, int lg);
__device__ __forceinline__ void p0_prologue(Frame& F) {
    if ((int)blockIdx.x < 192) p0_mod_item(F, blockIdx.x);
    for (int lg = F.G - 1 - (int)blockIdx.x; lg < NL * NG; lg += F.G) p0_ssm_mats(F, lg);
    PHASE_IDS;
    LAS unsigned char* scr = F.lds + wave * 9216;
    const int gw = F.vcu * NWAVES + wave, NGW = F.G * NWAVES;
    constexpr int P0_BASE_ROUNDS = 25;
#pragma unroll 1
    for (int rd = 0; rd < P0_BASE_ROUNDS; ++rd) { const int it = gw + rd * NGW; if (it < P0_ITEMS) { f32x4 va[16]; const P0Tile ta = p0_tile_of(it); p0_load(ta, va, lane); p0_store(ta, va, scr, lane); } }
    if ((int)blockIdx.x >= 192 || F.G <= 192) {
        const int nfree = (F.G > 192 ? F.G - 192 : F.G) * NWAVES, fw = ((int)blockIdx.x - (F.G > 192 ? 192 : 0)) * NWAVES + wave;
#pragma unroll 1
        for (int it = P0_BASE_ROUNDS * NGW + fw; it < P0_ITEMS; it += nfree) { f32x4 va[16]; const P0Tile ta = p0_tile_of(it); p0_load(ta, va, lane); p0_store(ta, va, scr, lane); }
    }
    for (int fi = gw; fi < RW_FRAGS; fi += NGW) p0_router_frag(F, fi, lane);
}


template <int MODE  , bool has_y>
__device__ __forceinline__ void pn_rows(Frame& F, int l, const float* xin, int lp) {
    unsigned char* ws = KP->ws;
    const float* mod = (const float*)(ws + WS_MOD);
    PHASE_IDS;
    const int row0 = F.vcu * 64 + wave * 8, b = (F.vcu * 64) >> 11;
    LAS f32x4* Lg = (LAS f32x4*)F.lds;
    LAS f32x4* Lsh = Lg + 512;
    LAS f32x4* Lg2 = Lg + 1024;
    {
        const int i = tid;
        if (MODE == 0) { const f32x4 g = ((const f32x4*)(KP->norm1_g + l * D))[i]; const f32x4* sh = (const f32x4*)(mod + ((size_t)l * NB + b) * 6 * D); Lg[i] = g * (1.f + sh[D / 4 + i]); Lsh[i] = sh[i]; }
        else Lg[i] = ((const f32x4*)KP->final_g)[i];
        if (has_y) Lg2[i] = ((const f32x4*)(mod + ((size_t)lp * NB + b) * 6 * D + 5 * D))[i];
    }
    __syncthreads();
    f32x4 xa[has_y ? 1 : 8], xb[has_y ? 1 : 8]; v2u ra[has_y ? 8 : 1], rb[has_y ? 8 : 1], ya0[has_y ? 8 : 1], ya1[has_y ? 8 : 1], yb0[has_y ? 8 : 1], yb1[has_y ? 8 : 1], da[1], db[1];
#define PN_LOAD(XF, XR, Y0, Y1, DD, row) do { \
        if constexpr (!has_y) { const f32x4* xr_ = (const f32x4*)(xin + (size_t)(row) * D) + lane; _Pragma("unroll") for (int j = 0; j < 8; ++j) XF[j] = __builtin_nontemporal_load(xr_ + 64 * j); } \
        else { const v2u* x_ = (const v2u*)((const bf16*)(ws + WS_XB) + (size_t)(row) * D) + lane; const v2u* y0_ = (const v2u*)((const bf16*)(ws + WS_Y) + (size_t)(row) * D) + lane; const v2u* y1_ = (const v2u*)((const bf16*)(ws + WS_Y) + ((size_t)T + (row)) * D) + lane; \
            _Pragma("unroll") for (int j = 0; j < 8; ++j) { XR[j] = __builtin_nontemporal_load(x_ + 64 * j); Y0[j] = __builtin_nontemporal_load(y0_ + 64 * j); Y1[j] = __builtin_nontemporal_load(y1_ + 64 * j); } } } while (0)
#define PN_PROC(XF, XR, Y0, Y1, DD, row) do { f32x4 X[8]; \
        if constexpr (!has_y) { _Pragma("unroll") for (int j = 0; j < 8; ++j) X[j] = XF[j]; } \
        else { _Pragma("unroll") for (int j = 0; j < 8; ++j) { const v2u x = XR[j], a = Y0[j], c = Y1[j]; const f32x4 g = Lg2[64 * j + lane]; \
            X[j][0] = __uint_as_float(x.x << 16) + g[0] * (__uint_as_float(a.x << 16) + __uint_as_float(c.x << 16)); X[j][1] = __uint_as_float(x.x & 0xffff0000u) + g[1] * (__uint_as_float(a.x & 0xffff0000u) + __uint_as_float(c.x & 0xffff0000u)); \
            X[j][2] = __uint_as_float(x.y << 16) + g[2] * (__uint_as_float(a.y << 16) + __uint_as_float(c.y << 16)); X[j][3] = __uint_as_float(x.y & 0xffff0000u) + g[3] * (__uint_as_float(a.y & 0xffff0000u) + __uint_as_float(c.y & 0xffff0000u)); } } \
        __builtin_amdgcn_sched_barrier(0); \
        if (MODE == 0) { v2u* xo_ = (v2u*)((bf16*)(ws + WS_XB) + (size_t)(row) * D) + lane; _Pragma("unroll") for (int j = 0; j < 8; ++j) { v2u o; o.x = pk2(X[j][0], X[j][1]); o.y = pk2(X[j][2], X[j][3]); __builtin_nontemporal_store(o, xo_ + 64 * j); } } \
        float ss_ = 0.f; _Pragma("unroll") for (int j = 0; j < 8; ++j) ss_ += (X[j][0] * X[j][0] + X[j][1] * X[j][1]) + (X[j][2] * X[j][2] + X[j][3] * X[j][3]); \
        const float rstd_ = 1.f / sqrtf(wave_sum(ss_) * (1.f / D) + EPS); \
        __builtin_amdgcn_sched_barrier(0); \
        if (MODE == 2) { f32x4* o_ = (f32x4*)(KP->out + (size_t)(row) * D) + lane; _Pragma("unroll") for (int j = 0; j < 8; ++j) __builtin_nontemporal_store(X[j] * rstd_ * Lg[64 * j + lane], o_ + 64 * j); } \
        else { v2u* H_ = (v2u*)((bf16*)(ws + WS_H) + (size_t)(row) * D) + lane; \
            _Pragma("unroll") for (int j = 0; j < 8; ++j) { const f32x4 h = X[j] * rstd_ * Lg[64 * j + lane] + Lsh[64 * j + lane]; v2u o; o.x = pk2(h[0], h[1]); o.y = pk2(h[2], h[3]); H_[64 * j] = o; } } } while (0)
    PN_LOAD(xa, ra, ya0, ya1, da, row0);
#pragma unroll 1
    for (int r = 0; r < 8; r += 2) {
        PN_LOAD(xb, rb, yb0, yb1, db, row0 + r + 1); __builtin_amdgcn_sched_barrier(0);
        PN_PROC(xa, ra, ya0, ya1, da, row0 + r); __builtin_amdgcn_sched_barrier(0);
        if (r + 2 < 8) PN_LOAD(xa, ra, ya0, ya1, da, row0 + r + 2);
        __builtin_amdgcn_sched_barrier(0);
        PN_PROC(xb, rb, yb0, yb1, db, row0 + r + 1); __builtin_amdgcn_sched_barrier(0);
    }
#undef PN_LOAD
#undef PN_PROC
    __syncthreads();
}

__device__ __forceinline__ void p0_router_frag(Frame& F, int fi, int lane) {
    const int l = fi / 192, r = fi % 192, ks = r / 3, cb = r % 3;
    const int col = cb * 16 + (lane & 15), k0 = ks * 32 + 8 * (lane >> 4);
    f16x8 h;
#pragma unroll
    for (int q = 0; q < 8; ++q) { const int k = k0 + q;
        const float w = (col < 4) ? KP->rg_w[((size_t)l * D + k) * NGR + col] : (col < 36) ? KP->re_w[(((size_t)l * NGR + ((col - 4) >> 3)) * D + k) * EPG + ((col - 4) & 7)] : 0.f;
        h[q] = (_Float16)w; }
    ((v4u*)(KP->ws + WS_RW))[(size_t)fi * 64 + lane] = __builtin_bit_cast(v4u, h);
}

constexpr int PN2_TS = 2052;
__device__ __forceinline__ void pn2_phase(Frame& F, int l, bool commit) {
    unsigned char* ws = KP->ws;
    const float* mod = (const float*)(ws + WS_MOD);
    PHASE_IDS;
    LAS float* tile = (LAS float*)F.lds;
    LAS f32x4* Lg = (LAS f32x4*)(F.lds + 16 * PN2_TS * 4);
    LAS f32x4* Lsh = Lg + 512;
    LAS int* lcnt = (LAS int*)(F.lds + L_CNT);
    LAS int* lbase = (LAS int*)(F.lds + L_PTILE);
    LAS int* ent = (LAS int*)(F.lds + L_TAB);
    const int rowbase = F.vcu * 64;
    LAS float* rbias = (LAS float*)(F.lds + 16 * PN2_TS * 4 + 16384);
    v2u xa[2][8], xb[2][8];
#define PN2_LOAD(blk_, p_) do { const int ln_ = fresh_tid(F.wv) & 63; const v2u* xr_ = (const v2u*)((const bf16*)(ws + WS_XB) + (size_t)(rowbase + (blk_) * 16 + 2 * wave) * D) + ln_; \
        _Pragma("unroll") for (int j = 0; j < 8; ++j) { xa[p_][j] = __builtin_nontemporal_load(xr_ + 64 * j); xb[p_][j] = __builtin_nontemporal_load(xr_ + D / 4 + 64 * j); } } while (0)
#define PN2_ROW(XR, r_) do { f32x4 X[8]; _Pragma("unroll") for (int j = 0; j < 8; ++j) { const v2u x = XR[j]; X[j][0] = __uint_as_float(x.x << 16); X[j][1] = __uint_as_float(x.x & 0xffff0000u); X[j][2] = __uint_as_float(x.y << 16); X[j][3] = __uint_as_float(x.y & 0xffff0000u); } \
        float ss_ = 0.f; _Pragma("unroll") for (int j = 0; j < 8; ++j) ss_ += (X[j][0] * X[j][0] + X[j][1] * X[j][1]) + (X[j][2] * X[j][2] + X[j][3] * X[j][3]); \
        const float rstd_ = 1.f / sqrtf(wave_sum(ss_) * (1.f / D) + EPS); v2u* H_ = (v2u*)((bf16*)(ws + WS_H) + (size_t)(rowbase + blk * 16 + (r_)) * D) + lane; \
        _Pragma("unroll") for (int j = 0; j < 8; ++j) { const f32x4 h = X[j] * rstd_ * Lg[64 * j + lane] + Lsh[64 * j + lane]; v2u o; o.x = pk2(h[0], h[1]); o.y = pk2(h[2], h[3]); H_[64 * j] = o; \
            *(LAS f32x4*)(tile + (r_) * PN2_TS + 256 * j + 4 * lane) = h; } } while (0)
    PN2_LOAD(0, 0); PN2_LOAD(1, 1);
    v4u bw[8][3];
    {   const v4u* rw = (const v4u*)(ws + WS_RW) + ((size_t)l * 192 + (size_t)(wave * 8) * 3) * 64 + lane;
#pragma unroll
        for (int q = 0; q < 8; ++q)
#pragma unroll
            for (int cb = 0; cb < 3; ++cb) bw[q][cb] = rw[(size_t)(q * 3 + cb) * 64]; }
    {
        const int b = rowbase >> 11; const f32x4 g = ((const f32x4*)(KP->norm2_g + l * D))[tid]; const f32x4* sh = (const f32x4*)(mod + ((size_t)l * NB + b) * 6 * D + 3 * D);
        Lg[tid] = g * (1.f + sh[D / 4 + tid]); Lsh[tid] = sh[tid];
        if (tid < NE) lcnt[tid] = 0;
        if (tid < 36) rbias[tid] = (tid < 4) ? KP->rg_b[l * NGR + tid] : KP->re_b[l * NGR * EPG + tid - 4];
    }
    __syncthreads();
#pragma unroll
    for (int blk = 0; blk < 4; ++blk) {
        PN2_ROW(xa[blk & 1], 2 * wave); __builtin_amdgcn_sched_barrier(0);
        PN2_ROW(xb[blk & 1], 2 * wave + 1);
        __builtin_amdgcn_sched_barrier(0);
        if (blk + 2 < 4) PN2_LOAD(blk + 2, blk & 1);
        __builtin_amdgcn_sched_barrier(0);
        __syncthreads();
        f32x4 acc[3];
#pragma unroll
        for (int cb = 0; cb < 3; ++cb) acc[cb] = (f32x4){0.f, 0.f, 0.f, 0.f};
#pragma unroll
        for (int q = 0; q < 8; ++q) {
            const LAS float* tp = tile + (lane & 15) * PN2_TS + (wave * 8 + q) * 32 + 8 * (lane >> 4);
            const f32x4 x0 = *(const LAS f32x4*)tp, x1 = *(const LAS f32x4*)(tp + 4);
            f16x8 a_hi, a_lo;
            { const float xs[8] = {x0[0], x0[1], x0[2], x0[3], x1[0], x1[1], x1[2], x1[3]};
#pragma unroll
              for (int jj = 0; jj < 4; ++jj) { const f16x2 hp = __builtin_bit_cast(f16x2, __builtin_amdgcn_cvt_pkrtz(xs[2 * jj], xs[2 * jj + 1]));
                  const f16x2 lp = __builtin_bit_cast(f16x2, __builtin_amdgcn_cvt_pkrtz(xs[2 * jj] - (float)hp[0], xs[2 * jj + 1] - (float)hp[1]));
                  a_hi[2 * jj] = hp[0]; a_hi[2 * jj + 1] = hp[1]; a_lo[2 * jj] = lp[0]; a_lo[2 * jj + 1] = lp[1]; } }
#pragma unroll
            for (int cb = 0; cb < 3; ++cb) { const f16x8 b = __builtin_bit_cast(f16x8, bw[q][cb]);
                acc[cb] = __builtin_amdgcn_mfma_f32_16x16x32_f16(a_hi, b, acc[cb], 0, 0, 0);
                acc[cb] = __builtin_amdgcn_mfma_f32_16x16x32_f16(a_lo, b, acc[cb], 0, 0, 0); }
        }
        __builtin_amdgcn_sched_barrier(0);
        __syncthreads();
        LAS f32x4* part = (LAS f32x4*)F.lds;
#pragma unroll
        for (int cb = 0; cb < 3; ++cb) part[(wave * 3 + cb) * 64 + lane] = acc[cb];
        __syncthreads();
        LAS float* lg = (LAS float*)(F.lds + 32768);
        for (int o = tid; o < 16 * 36; o += NTHR) { const int row = o / 36, col = o % 36, cb = col >> 4, ln = (row >> 2) * 16 + (col & 15); float s = 0.f;
#pragma unroll
            for (int w = 0; w < 8; ++w) s += ((const LAS float*)(part + (w * 3 + cb) * 64 + ln))[row & 3];
            lg[o] = s; }
        __syncthreads();
        if (tid < 16) {
            const int row = rowbase + blk * 16 + tid; const LAS float* q = lg + tid * 36;
            float gl[4]; int gi = 0;
#pragma unroll
            for (int n = 0; n < 4; ++n) gl[n] = q[n] + rbias[n];
#pragma unroll
            for (int n = 1; n < 4; ++n) if (gl[n] > gl[gi]) gi = n;
            float den = 0.f;
#pragma unroll
            for (int n = 0; n < 4; ++n) den += expf(gl[n] - gl[gi]);
            const float gw = 1.f / den;
            float el[8];
#pragma unroll
            for (int e = 0; e < 8; ++e) el[e] = q[4 + gi * 8 + e] + rbias[4 + gi * 8 + e];
            int i1 = 0;
#pragma unroll
            for (int e = 1; e < 8; ++e) if (el[e] > el[i1]) i1 = e;
            int i2 = (i1 == 0) ? 1 : 0;
#pragma unroll
            for (int e = 0; e < 8; ++e) if (e != i1 && el[e] > el[i2]) i2 = e;
            const float e2 = expf(el[i2] - el[i1]); const float w1 = gw / (1.f + e2), w2 = gw * e2 / (1.f + e2);
            float* tw = (float*)(ws + WS_TOKW);
            *(f32x2v*)(tw + row * 2) = (f32x2v){w1, w2};
            const int ea = gi * 8 + i1, eb = gi * 8 + i2;
            const int ra = atomicAdd((int*)(lcnt + ea), 1), rb = atomicAdd((int*)(lcnt + eb), 1);
            LAS int* en = ent + (blk * 32 + 2 * tid) * 3;
            en[0] = ea; en[1] = row * 2; en[2] = ra; en[3] = eb; en[4] = row * 2 + 1; en[5] = rb;
        }
        __syncthreads();
    }
#undef PN2_LOAD
#undef PN2_ROW
    if (commit) {
    if (tid < NE) { const int c = lcnt[tid]; lbase[tid] = c ? (int)__hip_atomic_fetch_add((unsigned*)(ws + WS_CTL) + CW_CNT + l * NE + tid, (unsigned)c, __ATOMIC_RELAXED, __HIP_MEMORY_SCOPE_AGENT) : 0; }
    __syncthreads();
    if (tid < 128) { const LAS int* en = ent + tid * 3; ((unsigned*)(ws + WS_LIST))[(size_t)en[0] * T + lbase[en[0]] + en[2]] = (unsigned)en[1]; }
    }
    __syncthreads();
}

__device__ __forceinline__ void conv_tile(Frame& F, int l, int tile) {
    unsigned char* ws = KP->ws;
    PHASE_IDS;
    const int c0 = 2 * tid;
    const int row0 = tile * 32, t0 = row0 & (SEQ - 1);
    LAS float* C = (LAS float*)F.lds;
    {
        f32x2v w2[CW];
        const float* cw = KP->conv_w + (size_t)l * CW * CCH + c0;
#pragma unroll
        for (int k = 0; k < CW; ++k) w2[k] = *(const f32x2v*)(cw + k * CCH);
        const f32x2v cb = *(const f32x2v*)(KP->conv_b + l * CCH + c0);
        const bf16* Z = (const bf16*)(ws + WS_Z) + c0;
        unsigned zw[62];
#pragma unroll
        for (int i = 0; i < 62; ++i) { const int dt = i - (CW - 1); zw[i] = 0u; if (t0 + dt >= 0) zw[i] = __builtin_nontemporal_load((const unsigned*)(Z + (size_t)(row0 + dt) * CCH)); }
#pragma unroll
        for (int hh = 0; hh < 2; ++hh) {
            f32x2v z2[46];
#pragma unroll
            for (int i = 0; i < 46; ++i) z2[i] = (f32x2v){__uint_as_float(zw[hh * 16 + i] << 16), __uint_as_float(zw[hh * 16 + i] & 0xffff0000u)};
#pragma unroll
            for (int o = 0; o < 16; ++o) { f32x2v a = cb;
#pragma unroll
                for (int k = 0; k < CW; ++k) a = __builtin_elementwise_fma(w2[k], z2[o + k], a);
                *(LAS f32x2v*)(C + (hh * 16 + o) * CCH + c0) = a; }
        }
    }
    __syncthreads();
#pragma unroll
    for (int q = 0; q < 4; ++q) {
        const int tk = wave * 4 + q, row = row0 + tk;
        f32x4 v[4]; float s = 0.f;
#pragma unroll
        for (int j = 0; j < 4; ++j) { v[j] = *(const LAS f32x4*)(C + tk * CCH + 256 * j + 4 * lane); s += (v[j][0] + v[j][1]) + (v[j][2] + v[j][3]); }
        const float mu = wave_sum(s) * (1.f / CCH); float qq = 0.f;
#pragma unroll
        for (int j = 0; j < 4; ++j) { v[j] = v[j] - mu; qq += (v[j][0] * v[j][0] + v[j][1] * v[j][1]) + (v[j][2] * v[j][2] + v[j][3] * v[j][3]); }
        const float rstd = 1.f / sqrtf(wave_sum(qq) * (1.f / CCH) + EPS);
        float q2 = 0.f;
#pragma unroll
        for (int j = 0; j < 4; ++j) { const f32x4 g = *((const f32x4*)(KP->conv_ln_g + l * CCH) + 64 * j + lane), bb = *((const f32x4*)(KP->conv_ln_b + l * CCH) + 64 * j + lane);
#pragma unroll
            for (int i = 0; i < 4; ++i) { const float y = v[j][i] * rstd * g[i] + bb[i]; v[j][i] = siluf_(y); q2 += v[j][i] * v[j][i]; } }
        const float r2 = 1.f / sqrtf(wave_sum(q2) * (1.f / CCH) + EPS);
        v2u* ao = (v2u*)((bf16*)(ws + WS_AO) + (size_t)row * D + SCH) + lane;
#pragma unroll
        for (int j = 0; j < 4; ++j) { const f32x4 g = *((const f32x4*)(KP->onc_g + l * CCH) + 64 * j + lane); v2u o; o.x = pk2(v[j][0] * r2 * g[0], v[j][1] * r2 * g[1]); o.y = pk2(v[j][2] * r2 * g[2], v[j][3] * r2 * g[3]); ao[64 * j] = o; }
    }
    __syncthreads();
}


constexpr size_t SSMM_STRIDE = 256 * 1024, SSMM_WM = 192 * 1024;
__device__ __forceinline__ void p0_ssm_mats(Frame& F, int lg) {
    PHASE_IDS;
    const int l = lg / NG, g = lg % NG;
    LAS float* PWr = (LAS float*)F.lds;
    LAS float* PWi = PWr + 17 * 64;
    LAS float* BBr = PWi + 17 * 64;
    LAS float* BBi = BBr + 1024;
    LAS float* CCr = BBi + 1024;
    LAS float* CCi = CCr + 1024;
    LAS float* KT = CCi + 1024;
    LAS float* DS = KT + 4096;
    const float dt = expf(KP->log_dt[l * NG + g]);
    for (int i = tid; i < 17 * 64; i += NTHR) { const int k = i >> 6, p = i & 63; const float lr = KP->a_re[(l * NG + g) * NP + p], li = KP->a_im[(l * NG + g) * NP + p];
        const float mag = expf(lr * dt * (float)k), ang = li * dt * (float)k; PWr[i] = mag * cosf(ang); PWi[i] = mag * sinf(ang); }
    for (int i = tid; i < 1024; i += NTHR) { const int p = i >> 4, h = i & 15; const float lr = KP->a_re[(l * NG + g) * NP + p], li = KP->a_im[(l * NG + g) * NP + p];
        const float mag = expf(lr * dt), ang = li * dt, ar = mag * cosf(ang), ai = mag * sinf(ang), den = lr * lr + li * li, nr = ar - 1.f, ni = ai;
        const float fr = (nr * lr + ni * li) / den, fi = (ni * lr - nr * li) / den;
        const float br = KP->b_re[((size_t)(l * NG + g) * NP + p) * GW + h], bi = KP->b_im[((size_t)(l * NG + g) * NP + p) * GW + h];
        BBr[i] = fr * br - fi * bi; BBi[i] = fr * bi + fi * br;
        CCr[i] = KP->c_re[(size_t)(l * NG + g) * GW * NP + i]; CCi[i] = KP->c_im[(size_t)(l * NG + g) * GW * NP + i]; }
    if (tid < 16) DS[tid] = KP->ssm_d[l * SCH + g * GW + tid];
    if (tid < 64) { float* a16 = (float*)(KP->ws + WS_A16) + ((size_t)lg * NP + tid) * 2; const float lr = KP->a_re[(l * NG + g) * NP + tid], li = KP->a_im[(l * NG + g) * NP + tid];
        const float mag = expf(lr * dt * 16.f), ang = li * dt * 16.f; a16[0] = mag * cosf(ang); a16[1] = mag * sinf(ang); }
    __syncthreads();
    {
        const int k = tid >> 5, h = (tid >> 1) & 15, h0 = (tid & 1) * 8;
        float acc[8];
#pragma unroll
        for (int j = 0; j < 8; ++j) acc[j] = 0.f;
        for (int p = 0; p < 64; ++p) { const float cr = CCr[h * 64 + p], ci = CCi[h * 64 + p], pr = PWr[k * 64 + p], pi = PWi[k * 64 + p];
            const float zr = cr * pr - ci * pi, zi = cr * pi + ci * pr;
#pragma unroll
            for (int j = 0; j < 8; ++j) acc[j] += zr * BBr[p * 16 + h0 + j] - zi * BBi[p * 16 + h0 + j]; }
#pragma unroll
        for (int j = 0; j < 8; ++j) KT[(k * 16 + h) * 16 + h0 + j] = acc[j];
    }
    __syncthreads();
    v4u* tvf = (v4u*)(KP->ws + WS_SSMM + (size_t)lg * SSMM_STRIDE);
    v4u* wmf = (v4u*)(KP->ws + WS_SSMM + (size_t)lg * SSMM_STRIDE + SSMM_WM);
    const int fr = lane & 15, fq = lane >> 4;
    for (int f = wave; f < 192; f += NWAVES) {
        const int nt = f / 12, ks = f % 12, tau = nt, h = fr; float v[8];
        if (ks < 8) { const int sg = 2 * ks + (fq >> 1), h0 = 8 * (fq & 1), lag = tau - sg;
#pragma unroll
            for (int j = 0; j < 8; ++j) { float x = (lag >= 0) ? KT[(lag * 16 + h) * 16 + h0 + j] : 0.f; if (lag == 0 && h0 + j == h) x += DS[h]; v[j] = x; }
        } else { const int j0 = (ks - 8) * 32 + 8 * fq;
#pragma unroll
            for (int q = 0; q < 4; ++q) { const int p = (j0 >> 1) + q; const float cr = CCr[h * 64 + p], ci = CCi[h * 64 + p], pr = PWr[(tau + 1) * 64 + p], pi = PWi[(tau + 1) * 64 + p];
                v[2 * q] = cr * pr - ci * pi; v[2 * q + 1] = -(cr * pi + ci * pr); }
        }
        tvf[(size_t)f * 64 + lane] = (v4u){pk2(v[0], v[1]), pk2(v[2], v[3]), pk2(v[4], v[5]), pk2(v[6], v[7])};
    }
    for (int f = wave; f < 64; f += NWAVES) {
        const int nt = f >> 3, ks = f & 7, j = nt * 16 + fr, p = j >> 1, c = j & 1, sg = 2 * ks + (fq >> 1), h0 = 8 * (fq & 1); float v[8];
        const float pr = PWr[(15 - sg) * 64 + p], pi = PWi[(15 - sg) * 64 + p];
#pragma unroll
        for (int q = 0; q < 8; ++q) { const float br = BBr[p * 16 + h0 + q], bi = BBi[p * 16 + h0 + q]; v[q] = c ? (pr * bi + pi * br) : (pr * br - pi * bi); }
        wmf[(size_t)f * 64 + lane] = (v4u){pk2(v[0], v[1]), pk2(v[2], v[3]), pk2(v[4], v[5]), pk2(v[6], v[7])};
    }
    __syncthreads();
}

constexpr int SSM_RS = 528;
__device__ __forceinline__ void ssm_unit(Frame& F, int l, int b, int g) {
    PHASE_IDS;
    unsigned char* ws = KP->ws;
    const int fr = lane & 15, fq = lane >> 4, lg = l * NG + g;
    const int ntl = wave, nth = 15 - wave, kl = ntl >> 1, kh = nth >> 1;
    LAS unsigned char* Al = F.lds;
    LAS unsigned char* El = F.lds + 128 * SSM_RS;
    const v4u* tvf = (const v4u*)(ws + WS_SSMM + (size_t)lg * SSMM_STRIDE) + lane;
    const v4u* wmf = (const v4u*)(ws + WS_SSMM + (size_t)lg * SSMM_STRIDE + SSMM_WM) + lane;
    v4u w1[8], tl[4], th[8], sl[4], sh[4];
#pragma unroll
    for (int ks = 0; ks < 8; ++ks) w1[ks] = wmf[(size_t)(wave * 8 + ks) * 64];
#pragma unroll
    for (int ks = 0; ks < 4; ++ks) { tl[ks] = (v4u){0u, 0u, 0u, 0u}; if (ks <= kl) tl[ks] = tvf[(size_t)(ntl * 12 + ks) * 64]; }
#pragma unroll
    for (int ks = 0; ks < 8; ++ks) { th[ks] = (v4u){0u, 0u, 0u, 0u}; if (ks <= kh) th[ks] = tvf[(size_t)(nth * 12 + ks) * 64]; }
#pragma unroll
    for (int ks = 0; ks < 4; ++ks) { sl[ks] = tvf[(size_t)(ntl * 12 + 8 + ks) * 64]; sh[ks] = tvf[(size_t)(nth * 12 + 8 + ks) * 64]; }
    {
        const v4u* src = (const v4u*)((const bf16*)(ws + WS_U) + ((size_t)b * NG + g) * SEQ * GW);
        v4u av[8];
#pragma unroll
        for (int it = 0; it < 8; ++it) av[it] = src[it * NTHR + tid];
#pragma unroll
        for (int it = 0; it < 8; ++it) { const int idx = it * NTHR + tid; *(LAS v4u*)(Al + (idx >> 5) * SSM_RS + (idx & 31) * 16) = av[it]; }
    }
    __syncthreads();
#define SSM_AFR(dst, base, koff) do { _Pragma("unroll") for (int m = 0; m < 8; ++m) dst[m] = *(const LAS bf16x8*)((base) + (m * 16 + fr) * SSM_RS + (koff)); } while (0)
    {
        f32x4 acc[8];
#pragma unroll
        for (int m = 0; m < 8; ++m) acc[m] = (f32x4){0.f, 0.f, 0.f, 0.f};
#pragma unroll
        for (int ks = 0; ks < 8; ++ks) { bf16x8 afr[8]; SSM_AFR(afr, Al, (ks * 32 + 8 * fq) * 2); const bf16x8 bfr = __builtin_bit_cast(bf16x8, w1[ks]);
#pragma unroll
            for (int m = 0; m < 8; ++m) acc[m] = __builtin_amdgcn_mfma_f32_16x16x32_bf16(bfr, afr[m], acc[m], 0, 0, 0); }
#pragma unroll
        for (int m = 0; m < 8; ++m) *(LAS f32x4*)(El + (m * 16 + fr) * SSM_RS + (wave * 16 + 4 * fq) * 4) = acc[m];
    }
    __syncthreads();
    {
        const f32x2v a16 = *(const f32x2v*)((const float*)(ws + WS_A16) + ((size_t)lg * NP + lane) * 2);
        LAS f32x2v* SE = (LAS f32x2v*)(F.lds + 2 * 128 * SSM_RS);
        f32x2v e[16];
#pragma unroll
        for (int c = 0; c < 16; ++c) e[c] = *(const LAS f32x2v*)(El + (wave * 16 + c) * SSM_RS + lane * 8);
        float lr[16], li[16]; float sr = 0.f, si = 0.f;
#pragma unroll
        for (int c = 0; c < 16; ++c) { lr[c] = sr; li[c] = si; const float nr = a16.x * sr - a16.y * si + e[c].x, ni = a16.x * si + a16.y * sr + e[c].y; sr = nr; si = ni; }
        SE[wave * 64 + lane] = (f32x2v){sr, si};
        float pr = a16.x, pi = a16.y;
#pragma unroll
        for (int q = 0; q < 4; ++q) { const float tr = pr * pr - pi * pi, ti = 2.f * pr * pi; pr = tr; pi = ti; }
        __syncthreads();
        float cr = 0.f, ci = 0.f;
        for (int v = 0; v < wave; ++v) { const f32x2v s = SE[v * 64 + lane]; const float nr = pr * cr - pi * ci + s.x, ni = pr * ci + pi * cr + s.y; cr = nr; ci = ni; }
#pragma unroll
        for (int c = 0; c < 16; ++c) { *(LAS unsigned*)(El + (wave * 16 + c) * SSM_RS + lane * 4) = pk2(lr[c] + cr, li[c] + ci);
            const float nr = a16.x * cr - a16.y * ci, ni = a16.x * ci + a16.y * cr; cr = nr; ci = ni; }
    }
    const bf16* SGp = (const bf16*)(ws + WS_SG) + ((size_t)b * NG + g) * SEQ * GW;
    v2u sgw[8][2];
#pragma unroll
    for (int m = 0; m < 8; ++m) { sgw[m][0] = *(const v2u*)(SGp + (size_t)((m * 16 + fr) * 16 + ntl) * GW + 4 * fq); sgw[m][1] = *(const v2u*)(SGp + (size_t)((m * 16 + fr) * 16 + nth) * GW + 4 * fq); }
    __syncthreads();
    {
        f32x4 acc[8][2];
#pragma unroll
        for (int m = 0; m < 8; ++m) { acc[m][0] = (f32x4){0.f, 0.f, 0.f, 0.f}; acc[m][1] = (f32x4){0.f, 0.f, 0.f, 0.f}; }
#pragma unroll
        for (int ks = 0; ks < 8; ++ks) {
            if (ks <= kh) { bf16x8 afr[8]; SSM_AFR(afr, Al, (ks * 32 + 8 * fq) * 2);
                const bf16x8 bh = __builtin_bit_cast(bf16x8, th[ks]);
#pragma unroll
                for (int m = 0; m < 8; ++m) acc[m][1] = __builtin_amdgcn_mfma_f32_16x16x32_bf16(bh, afr[m], acc[m][1], 0, 0, 0);
                if (ks < 4) { if (ks <= kl) { const bf16x8 bl = __builtin_bit_cast(bf16x8, tl[ks < 4 ? ks : 0]);
#pragma unroll
                    for (int m = 0; m < 8; ++m) acc[m][0] = __builtin_amdgcn_mfma_f32_16x16x32_bf16(bl, afr[m], acc[m][0], 0, 0, 0); } }
            }
        }
#pragma unroll
        for (int ks = 0; ks < 4; ++ks) { bf16x8 afr[8]; SSM_AFR(afr, El, (ks * 32 + 8 * fq) * 2);
            const bf16x8 bl = __builtin_bit_cast(bf16x8, sl[ks]), bh = __builtin_bit_cast(bf16x8, sh[ks]);
#pragma unroll
            for (int m = 0; m < 8; ++m) { acc[m][0] = __builtin_amdgcn_mfma_f32_16x16x32_bf16(bl, afr[m], acc[m][0], 0, 0, 0); acc[m][1] = __builtin_amdgcn_mfma_f32_16x16x32_bf16(bh, afr[m], acc[m][1], 0, 0, 0); } }
        bf16* AO = (bf16*)(ws + WS_AO); float* SSQ = (float*)(ws + WS_SSQ);
        const f32x4 gs = *(const f32x4*)(KP->ons_g + l * SCH + g * GW + 4 * fq);
#pragma unroll
        for (int m = 0; m < 8; ++m)
#pragma unroll
            for (int n = 0; n < 2; ++n) {
                const int tok = (m * 16 + fr) * 16 + (n ? nth : ntl);
                const v2u sw = sgw[m][n];
                const float s0 = __uint_as_float(sw.x << 16), s1 = __uint_as_float(sw.x & 0xffff0000u), s2 = __uint_as_float(sw.y << 16), s3 = __uint_as_float(sw.y & 0xffff0000u);
                const float v0 = gelu_tanh(acc[m][n][0]) * s0, v1 = gelu_tanh(acc[m][n][1]) * s1, v2 = gelu_tanh(acc[m][n][2]) * s2, v3 = gelu_tanh(acc[m][n][3]) * s3;
                float sq = (v0 * v0 + v1 * v1) + (v2 * v2 + v3 * v3);
                sq += shfl_xor_fresh(sq, 16); sq += shfl_xor_fresh(sq, 32);
                const size_t row = (size_t)b * SEQ + tok;
                v2u o; o.x = pk2(v0 * gs[0], v1 * gs[1]); o.y = pk2(v2 * gs[2], v3 * gs[3]);
                *(v2u*)(AO + row * D + g * GW + 4 * fq) = o;
                if (fq == 0) SSQ[row * NG + ((g >> 2) & 7) * 8 + (g >> 5) * 4 + (g & 3)] = sq;
            }
    }
#undef SSM_AFR
    __syncthreads();
}

__device__ __forceinline__ void moe_tables(Frame& F, int l) {
    LAS int* pt = (LAS int*)(F.lds + L_PTILE); LAS int* lc = (LAS int*)(F.lds + L_CNT);
    const int tq = fresh_tid(F.wv);
    if (tq < NE) lc[tq] = (int)__hip_atomic_load((const unsigned*)(KP->ws + WS_CTL) + CW_CNT + l * NE + tq, __ATOMIC_RELAXED, __HIP_MEMORY_SCOPE_AGENT);
    __syncthreads();
    if (tq == 0) { int acc = 0; for (int e = 0; e < NE; ++e) { pt[e] = acc; acc += (lc[e] + 255) >> 8; } pt[NE] = acc; }
    __syncthreads();
}

struct MArgs { Ptrs p; int ph_lo, ph_hi, use_bar, mix_mask; };
__global__ void __launch_bounds__(NTHR, 2) mega(MArgs args) {
    extern __shared__ __attribute__((aligned(16))) unsigned char lds_raw[];
    Frame F;
    F.lds = (LAS unsigned char*)lds_raw;
    F.wv = __builtin_amdgcn_readfirstlane((int)threadIdx.x >> 6);
    F.G = gridDim.x; { const int bx = blockIdx.x; F.vcu = (F.G % 8 == 0) ? (bx % 8) * (F.G / 8) + bx / 8 : bx; }
    for (int u = fresh_tid(F.wv); u < (LDS_BYTES - LCTL_OFF) / 4; u += NTHR) ((LAS unsigned*)(F.lds + LCTL_OFF))[u] = 0u;
    __syncthreads();
    XcdBarrier bar; bar.bar = (unsigned*)(KP->ws + WS_CTL) + CW_BAR; bar.x = 0; bar.st = nullptr; bar.wv = F.wv;
    if (args.use_bar) bar = xcd_barrier_post((unsigned*)(KP->ws + WS_CTL) + CW_BAR, (volatile LAS unsigned*)(F.lds + L_MISC) + 8, F.wv);
    const int lo = args.ph_lo, hi = args.ph_hi;
#ifndef PROBE_DUP
#define PROBE_DUP -1
#endif
#define DUPN(k) ((PROBE_DUP == (k)) ? 2 : 1)
#define IN(k) (lo <= (k) && (k) < hi)
#define SEAM(k) do { if (IN(k) && IN((k) + 1)) xcd_barrier(bar); } while (0)
    for (int rep = 0; rep < DUPN(7); ++rep) { if (rep) xcd_barrier(bar);
    if (IN(0)) { p0_prologue(F); } }
    SEAM(0);
    for (int l = 0; l < NL; ++l) {
        const int pb = 1 + 7 * l;
#define WSP (KP->ws)
        for (int rep = 0; rep < DUPN(0); ++rep) { if (rep) xcd_barrier(bar);
        if (IN(pb + 0)) { if (l == 0) pn_rows<0, false>(F, l, KP->x, 0); else pn_rows<0, true>(F, l, nullptr, l - 1); } }
        SEAM(pb + 0);
        for (int rep = 0; rep < DUPN(1); ++rep) { if (rep) xcd_barrier(bar);
        if (IN(pb + 1)) {
            unsigned char* ws = WSP;
            pg8::Gemm g{(const bf16*)(ws + WS_H), (const bf16*)(ws + WS_WIN) + (size_t)l * INC * D, T, INC, D};
            pg8::StaticOrder S; S.init(T, INC, F.G, (int)blockIdx.x);
            EpiIn E{(bf16*)(ws + WS_Z), (bf16*)(ws + WS_U), (bf16*)(ws + WS_SG)};
            pg8::gemm_phase<EpiIn, pg8::StaticOrder, false, D>(F.lds, g, S, E, nullptr, F.wv);
        } }
        SEAM(pb + 1);
        for (int rep = 0; rep < DUPN(2); ++rep) { if (rep) xcd_barrier(bar);
        if (IN(pb + 2)) {
            if (args.mix_mask & 2) for (int u = (int)blockIdx.x; u < ((PROBE_DUP == 21) ? 2 : 1) * NB * NG; u += F.G) {
                const int g_ = ((u & 7) << 2) + ((u & 8) << 2) + ((u >> 4) & 3), b_ = ((u >> 6) & 3) + (((u >> 8) & 1) << 2);
                ssm_unit(F, l, b_, g_); }
            if (args.mix_mask & 1) for (int tl = F.vcu; tl < ((PROBE_DUP == 20) ? 2 : 1) * (T / 32); tl += F.G) conv_tile(F, l, tl % (T / 32));
        } }
        SEAM(pb + 2);
        for (int rep = 0; rep < DUPN(3); ++rep) { if (rep) xcd_barrier(bar);
        if (IN(pb + 3)) {
            unsigned char* ws = WSP;
            pg8::StaticOrder S; S.init(T, D, F.G, (int)blockIdx.x);
            LAS float* rs = (LAS float*)(F.lds + L_TAB);
            {
                pg8::Unit u0, u1; const bool ok0 = S.next(0, u0), ok1 = S.next(1, u1);
                const int tq = fresh_tid(F.wv), slot = tq >> 8, r = tq & 255; pg8::Unit u; u.pm = slot ? u1.pm : u0.pm;
                if (slot ? ok1 : ok0) { const f32x4* sq = (const f32x4*)((const float*)(ws + WS_SSQ) + (size_t)(u.pm * 256 + r) * NG); float s = 0.f;
#pragma unroll
                    for (int q = 0; q < 16; ++q) { const f32x4 v = sq[q]; s += (v[0] + v[1]) + (v[2] + v[3]); }
                    rs[slot * 256 + r] = 1.f / sqrtf(s * (1.f / SCH) + EPS); }
            }
            __syncthreads();
            pg8::Gemm g{(const bf16*)(ws + WS_AO), (const bf16*)(ws + WS_WOUT) + (size_t)l * D * D, T, D, D};
            EpiOut E{(bf16*)(ws + WS_XB), (const float*)(ws + WS_MOD) + (size_t)l * NB * 6 * D + 2 * D, rs};
            pg8::gemm_phase<EpiOut, pg8::StaticOrder, false, D>(F.lds, g, S, E, nullptr, F.wv);
        } }
        SEAM(pb + 3);
        for (int rep = 0; rep < DUPN(4); ++rep) { if (rep) xcd_barrier(bar);
        if (IN(pb + 4)) pn2_phase(F, l, rep == DUPN(4) - 1); }
        SEAM(pb + 4);
        for (int rep = 0; rep < DUPN(5); ++rep) { if (rep) xcd_barrier(bar);
        if (IN(pb + 5)) {
            unsigned char* ws = WSP;
            moe_tables(F, l);
            const LAS int* pt = (const LAS int*)(F.lds + L_PTILE); const LAS int* lc = (const LAS int*)(F.lds + L_CNT);
            pg8::MoeOrder S{pt, 4, F.G, F.vcu, __builtin_amdgcn_readfirstlane(pt[NE]) * 4, (PROBE_DUP == 15) ? 2 : 1};
            LAS int* tab = (LAS int*)(F.lds + L_TAB);
            {
                LAS int* sinfo = (LAS int*)(F.lds + L_CNT + 128);
#pragma unroll 1
                for (int s = 0; s < 4; ++s) { pg8::Unit u; const bool ok = S.next(s, u); if (fresh_tid(F.wv) == 0) { sinfo[2 * s] = ok ? u.e : -1; sinfo[2 * s + 1] = ok ? u.mloc : 0; } }
                __syncthreads();
                const int tq = fresh_tid(F.wv); unsigned ev[2];
#pragma unroll
                for (int j = 0; j < 2; ++j) { const int sl = (tq >> 8) + 2 * j, e = sinfo[2 * sl], idx = sinfo[2 * sl + 1] * 256 + (tq & 255); ev[j] = 0u;
                    if (e >= 0 && idx < lc[e]) ev[j] = ((const unsigned*)(ws + WS_LIST))[(size_t)e * T + idx]; }
#pragma unroll
                for (int j = 0; j < 2; ++j) tab[((tq >> 8) + 2 * j) * 256 + (tq & 255)] = (int)(ev[j] >> 1);
            }
            __syncthreads();
            pg8::Gemm g{(const bf16*)(ws + WS_H), (const bf16*)(ws + WS_GU) + (size_t)l * NE * 2 * FF * D, 0, 0, D};
            EpiMoe1 E{(bf16*)(ws + WS_HM), CW_HMC + l * 160 * 64};
            pg8::gemm_phase<EpiMoe1, pg8::MoeOrder, true, D>(F.lds, g, S, E, tab, F.wv);
        } }
#if defined(MOE_BARRIER)
        SEAM(pb + 5);
#endif
        for (int rep = 0; rep < DUPN(6); ++rep) { if (rep) xcd_barrier(bar);
        if (IN(pb + 6)) {
            unsigned char* ws = WSP;
            moe_tables(F, l);
            const LAS int* pt = (const LAS int*)(F.lds + L_PTILE); const LAS int* lc = (const LAS int*)(F.lds + L_CNT);
            const int tm_ = __builtin_amdgcn_readfirstlane(pt[NE]), r1_ = (tm_ * 4) % F.G;
#pragma unroll 1
            for (int part = 0; part < 2; ++part) {
                pg8::MoeOrder2 S{pt, 8, F.G, F.vcu, tm_ * 8, r1_, r1_ ? MOE2_PRE : 0, part};
                LAS unsigned* tent = (LAS unsigned*)(F.lds + L_TAB); LAS float* twt = (LAS float*)(F.lds + L_TAB + 7168);
                {
                    LAS int* sinfo = (LAS int*)(F.lds + L_CNT + 128);
                    unsigned* ctl = (unsigned*)(ws + WS_CTL);
                    bool any = false;
#pragma unroll 1
                    for (int s2 = 0; s2 < 8; ++s2) { pg8::Unit u; const bool ok = S.next(s2, u) && s2 < 7; any = any || ok;
                        if (fresh_tid(F.wv) == 0) { sinfo[2 * s2] = ok ? u.e : -1; sinfo[2 * s2 + 1] = ok ? u.mloc : 0; }
                        if (ok && fresh_wave(F.wv) == 0) { unsigned* w = ctl + CW_HMC + (l * 160 + u.pm) * 64; unsigned polls = 0;
                            while ((unsigned)__builtin_amdgcn_readfirstlane(__hip_atomic_load(w, __ATOMIC_RELAXED, __HIP_MEMORY_SCOPE_AGENT)) < 32u) {
                                if (++polls > (1u << 20)) { __hip_atomic_store(ctl + CW_TMO, 1u, __ATOMIC_RELAXED, __HIP_MEMORY_SCOPE_AGENT); break; }
                                __builtin_amdgcn_s_sleep(2); } } }
                    if (any && fresh_wave(F.wv) == 0) { __builtin_amdgcn_fence(__ATOMIC_ACQUIRE, "agent"); asm volatile("s_waitcnt vmcnt(0)" ::: "memory"); }
                    __syncthreads();
                    const int tq = fresh_tid(F.wv); unsigned ev[4]; float wv[4];
#pragma unroll
                    for (int j = 0; j < 4; ++j) { const int sl = (tq >> 8) + 2 * j, e = sinfo[2 * sl], idx = sinfo[2 * sl + 1] * 256 + (tq & 255); ev[j] = ~0u;
                        if (e >= 0 && idx < lc[e]) ev[j] = ((const unsigned*)(ws + WS_LIST))[(size_t)e * T + idx]; }
#pragma unroll
                    for (int j = 0; j < 4; ++j) wv[j] = (ev[j] != ~0u) ? ((const float*)(ws + WS_TOKW))[ev[j]] : 0.f;
#pragma unroll
                    for (int j = 0; j < 4; ++j) { const int sl = (tq >> 8) + 2 * j; if (sl < 7) { tent[sl * 256 + (tq & 255)] = ev[j]; twt[sl * 256 + (tq & 255)] = wv[j]; } }
                }
                __syncthreads();
                pg8::Gemm g{(const bf16*)(ws + WS_HM), (const bf16*)(ws + WS_DN) + (size_t)l * NE * D * FF, 0, 0, FF};
                EpiMoe2 E{(bf16*)(ws + WS_Y), tent, twt};
                pg8::gemm_phase<EpiMoe2, pg8::MoeOrder2, false, FF>(F.lds, g, S, E, nullptr, F.wv);
            }
        } }
        SEAM(pb + 6);
    }
    for (int rep = 0; rep < DUPN(8); ++rep) { if (rep) xcd_barrier(bar);
    if (IN(15)) pn_rows<2, true>(F, 0, nullptr, NL - 1); }
#undef WSP
#undef IN
#undef SEAM
}

extern "C" void kernel_launch(void* const* d_in, const int* in_sizes, int n_in, void* d_out, int out_size, void* d_ws, size_t ws_size, hipStream_t stream) {
    static int grid = 0;
    if (grid == 0) {
        if (n_in != 30 || ws_size < WS_END || out_size != T * D) { fprintf(stderr, "kernel_launch: unexpected n_in %d / out_size %d / ws_size %zu (need %zu)\n", n_in, out_size, ws_size, (size_t)WS_END); grid = -1; return; }
        int dev = 0, cus = 0, per_cu = 0;
        if (hipGetDevice(&dev) != hipSuccess || hipDeviceGetAttribute(&cus, hipDeviceAttributeMultiprocessorCount, dev) != hipSuccess) { grid = -1; return; }
        if (hipFuncSetAttribute((const void*)mega, hipFuncAttributeMaxDynamicSharedMemorySize, LDS_BYTES) != hipSuccess) { fprintf(stderr, "kernel_launch: hipFuncSetAttribute failed\n"); grid = -1; return; }
        if (hipOccupancyMaxActiveBlocksPerMultiprocessor(&per_cu, (const void*)mega, NTHR, LDS_BYTES) != hipSuccess || per_cu < 1) { fprintf(stderr, "kernel_launch: occupancy query reports %d workgroups per CU; nothing launched\n", per_cu); (void)hipGetLastError(); grid = -1; return; }
        if (cus != 256) { fprintf(stderr, "kernel_launch: built for 256 CUs, device has %d; nothing launched\n", cus); grid = -1; return; }
        grid = cus;
    }
    if (grid < 0) return;
    MArgs a{};
    const float** pp = (const float**)&a.p;
    for (int i = 0; i < 30; ++i) pp[i] = (const float*)d_in[i];
    a.p.out = (float*)d_out; a.p.ws = (unsigned char*)d_ws;
    a.ph_lo = 0; a.ph_hi = 16; a.use_bar = 1; a.mix_mask = 3;
    if (hipMemsetAsync((char*)d_ws + WS_CTL, 0, CTL_BYTES, stream) != hipSuccess) { fprintf(stderr, "kernel_launch: memset failed\n"); return; }
    hipLaunchKernelGGL(mega, dim3(grid), dim3(NTHR), LDS_BYTES, stream, a);
    const hipError_t le = hipPeekAtLastError();
    if (le != hipSuccess) fprintf(stderr, "kernel_launch: launch failed: %s\n", hipGetErrorName(le));
}
```

```cpp
#include <hip/hip_runtime.h>
#include <cstdio>
#include <cstdint>

constexpr int NB = 8, SEQ = 2048, D = 2048, T = NB * SEQ, NL = 2;
constexpr int CCH = 1024, SCH = 1024, CW = 31, NG = 64, GW = 16, NP = 64, INC = 4096;
constexpr int NE = 32, EPG = 8, NGR = 4, FF = 512;
constexpr float EPS = 1e-6f;

typedef unsigned short bf16;
typedef float f32x4 __attribute__((ext_vector_type(4)));
__device__ __forceinline__ float bf2f(bf16 v) { return __uint_as_float(((unsigned)v) << 16); }
__device__ __forceinline__ bf16 f2bf(float f) { unsigned u = __float_as_uint(f); return (bf16)((u + 0x7fffu + ((u >> 16) & 1u)) >> 16); }
__device__ __forceinline__ float sigmoidf_(float x) { return __builtin_amdgcn_rcpf(1.f + __expf(-x)); }
__device__ __forceinline__ float siluf_(float x) { return x * sigmoidf_(x); }
__device__ __forceinline__ float gelu_tanh(float y) { const float u = 1.5957691216057308f * (y + 0.044715f * y * y * y); return y * sigmoidf_(u); }

constexpr size_t MiB = 1u << 20;
constexpr size_t WS_CTL = 0, CTL_BYTES = 1 * MiB;
constexpr size_t WS_MOD = 1 * MiB;
constexpr size_t WS_SSMM = 2 * MiB;
constexpr size_t WS_A16 = 34 * MiB;
constexpr size_t WS_TOKE = 35 * MiB;
constexpr size_t WS_TOKW = 35 * MiB + 512 * 1024;
constexpr size_t WS_LIST = 36 * MiB;
constexpr size_t WS_SSQ = 38 * MiB;
constexpr size_t WS_RW = 42 * MiB;
constexpr size_t WS_WIN = 48 * MiB, WS_WOUT = 80 * MiB, WS_GU = 96 * MiB, WS_DN = 352 * MiB;
constexpr size_t WS_XA = 480 * MiB, WS_XB = 608 * MiB, WS_H = 736 * MiB;
constexpr size_t WS_Z = 800 * MiB, WS_U = 832 * MiB, WS_SG = 864 * MiB, WS_AO = 896 * MiB, WS_HM = 960 * MiB;
constexpr size_t WS_Y = 800 * MiB;
constexpr size_t WS_TMP = 1000 * MiB;
constexpr size_t WS_END = 1064 * MiB;
constexpr int CW_CNT = 1024;
constexpr int HM_ROWS = 2 * T + NE * 256;

struct Ptrs {
    const float *x, *c, *w_ada, *b_ada, *norm1_g, *w_in, *conv_w, *conv_b, *conv_ln_g, *conv_ln_b;
    const float *a_re, *a_im, *b_re, *b_im, *c_re, *c_im, *ssm_d, *log_dt, *onc_g, *ons_g, *w_out, *norm2_g;
    const float *rg_w, *rg_b, *re_w, *re_b, *w_gate, *w_up, *w_down, *final_g;
    float* out; unsigned char* ws;
};

#ifndef PROBE_REPS
#define PROBE_REPS 2
#endif
#ifndef PROBE_DUP
#define PROBE_DUP -1
#endif
__device__ __forceinline__ unsigned* ctl_words();
namespace pg8 {
#define PG8_LAS __attribute__((address_space(3)))
typedef unsigned short bf16_t;
typedef short bf16x8 __attribute__((ext_vector_type(8)));
typedef float f32x4 __attribute__((ext_vector_type(4)));
typedef unsigned u32x4 __attribute__((ext_vector_type(4)));
constexpr int BM = 256, BK = 64, HALF = 128, HTB = HALF * BK * 2, STAGE_BYTES = 8 * HTB, NXCD = 8, WGM = 4;

__host__ __device__ __forceinline__ int lds_byte(int r, int c) { const int st = (r >> 4) * 2 + (c >> 5), rr = r & 15, cc = c & 31, ob = rr * 64 + cc * 2; return st * 1024 + (ob ^ (((ob >> 9) & 1) << 5)); }
__host__ __device__ __forceinline__ void stage_rc(int b, int& R, int& C) { const int st = b / 1024, sb = b % 1024, swz = sb ^ (((sb >> 9) & 1) << 5); R = (st >> 1) * 16 + swz / 64; C = (st & 1) * 32 + (swz % 64) / 2; }
__host__ __device__ __forceinline__ int perm32(int rho) { const int n = rho >> 4, i = rho & 15; return 8 * (i >> 2) + 4 * n + (i & 3); }

struct Unit { int pm, pn, e, mloc; };
struct Gemm { const bf16_t* A; const bf16_t* Bt; int M, N, K; };

struct StaticOrder {
    int nM, nN, nwg, G, c;
    __device__ void init(int M, int N, int G_, int c_) { nM = M / BM; nN = N / BM; nwg = nM * nN; G = G_; c = c_; }
    __device__ bool next(int i, Unit& u) const {
        const long L = (long)i * G + c; if (L >= nwg) return false;
        int wgid = (int)L; { const int q = nwg / NXCD, r = nwg % NXCD, xcd = wgid % NXCD, off = wgid / NXCD; wgid = (xcd < r ? xcd * (q + 1) : r * (q + 1) + (xcd - r) * q) + off; }
        const int nig = WGM * nN, gid = wgid / nig, fm = gid * WGM, gsz = (nM - fm) < WGM ? (nM - fm) : WGM;
        u.pm = fm + ((wgid % nig) % gsz); u.pn = (wgid % nig) / gsz; u.e = 0; u.mloc = 0; return true;
    }
};
struct MoeOrder {
    const PG8_LAS int* ptile; int npn, G, c, total, rep;
    __device__ __forceinline__ void decode(int j, Unit& u) const {
        const int mt = j / npn, pn = j % npn;
        int ln_ = (int)__builtin_amdgcn_mbcnt_hi(~0u, __builtin_amdgcn_mbcnt_lo(~0u, 0u)); asm volatile("" : "+v"(ln_));
        const int pv = ptile[(ln_ & 31) + 1];
        const int e = __builtin_popcountll(__ballot(pv <= mt) & 0xffffffffull);
        u.pm = mt; u.pn = e * npn + pn; u.e = e; u.mloc = __builtin_amdgcn_readfirstlane(mt - ptile[e]);
    }
    __device__ bool next(int i, Unit& u) const {
        long L = (long)i * G + c; if (L >= (long)total * rep) return false;
        if (L >= total) L -= total;
        decode((int)L, u); return true;
    }
};
struct MoeOrder2 {
    const PG8_LAS int* ptile; int npn, G, c, total, r, pre, part;
    __device__ bool next(int i, Unit& u) const {
        const int preN = pre * (G - r); int j;
        if (part == 0) { if (c < r || i >= pre) return false; j = i * (G - r) + (c - r); }
        else j = preN + i * G + c;
        if (j >= total) return false;
        MoeOrder o{ptile, npn, G, c, total, 1}; o.decode(j, u); return true;
    }
};

__device__ __forceinline__ unsigned cvt_pk_bf16(float lo, float hi) { unsigned r; asm volatile("v_cvt_pk_bf16_f32 %0, %1, %2" : "=v"(r) : "v"(lo), "v"(hi)); return r; }

template <class Epi, class Sched, bool GATHER, int KC>
__device__ __forceinline__ void gemm_phase(PG8_LAS unsigned char* lds, const Gemm g, const Sched& S, const Epi& E, const PG8_LAS int* rowtab, const int wv) {
    int tid_ = wv * 64 + (int)__builtin_amdgcn_mbcnt_hi(~0u, __builtin_amdgcn_mbcnt_lo(~0u, 0u)); asm volatile("" : "+v"(tid_));
    const int tid = tid_, wid = wv, lane = tid & 63, wr = wid >> 2, wc = wid & 3, fr = lane & 15, fq = lane >> 4;
    constexpr int K = KC, nt = K / BK;
    unsigned voffA[2], voffB[2]; int Rr[2];
#pragma unroll
    for (int i = 0; i < 2; ++i) { int R, C; stage_rc(tid * 16 + i * 8192, R, C); const int Rb = Epi::PERM ? ((R & ~31) + perm32(R & 31)) : R;
        voffA[i] = GATHER ? (unsigned)(C * 2) : (unsigned)(R * K + C) * 2u; voffB[i] = (unsigned)(Rb * K + C) * 2u; Rr[i] = R; }
    constexpr size_t kstep = (size_t)(BK * 2);
    constexpr size_t hstep = (size_t)HALF * K * 2;
    constexpr size_t tstep = 2 * hstep;
    const unsigned ldsw = (unsigned)wid * 1024u;
    const int aoff = lds_byte(wr * 64 + fr, fq * 8), boff = lds_byte(wc * 32 + fr, fq * 8);
#define PG8_SA(b, h) (((b) * 2 + (h)) * HTB)
#define PG8_SB(b, h) ((4 + (b) * 2 + (h)) * HTB)
#define PG8_STAGE(bufoff, gbase, voff) do { _Pragma("unroll") for (int _i = 0; _i < 2; ++_i) \
        __builtin_amdgcn_global_load_lds((const unsigned*)((const char*)(gbase) + (voff)[_i]), (PG8_LAS unsigned*)(lds + (bufoff) + ldsw + _i * 8192), 16, 0, 0); } while (0)
#define PG8_STA(bufoff, usel, h, kb) do { if constexpr (GATHER) { unsigned _o[2]; _o[0] = (usel) ? gan[h][0] : gac[h][0]; _o[1] = (usel) ? gan[h][1] : gac[h][1]; PG8_STAGE(bufoff, gA + (kb), _o); } \
        else { PG8_STAGE(bufoff, ((usel) ? nA : cA) + (h) * hstep + (kb), voffA); } } while (0)
#define PG8_LDA(dst, b, h) do { _Pragma("unroll") for (int m = 0; m < 4; ++m) _Pragma("unroll") for (int k = 0; k < 2; ++k) dst[m][k] = *(const PG8_LAS bf16x8*)(lds + PG8_SA(b, h) + aoff + m * 2048 + k * 1024); } while (0)
#define PG8_LDB(dst, b, h) do { _Pragma("unroll") for (int n = 0; n < 2; ++n) _Pragma("unroll") for (int k = 0; k < 2; ++k) dst[n][k] = *(const PG8_LAS bf16x8*)(lds + PG8_SB(b, h) + boff + n * 2048 + k * 1024); } while (0)
#define PG8_MMA(ai, bj, At, Bt) do { __builtin_amdgcn_s_setprio(1); _Pragma("unroll") for (int m = 0; m < 4; ++m) _Pragma("unroll") for (int n = 0; n < 2; ++n) _Pragma("unroll") for (int k = 0; k < 2; ++k) \
        acc[ai][bj][m][n] = __builtin_amdgcn_mfma_f32_16x16x32_bf16(Bt[n][k], At[m][k], acc[ai][bj][m][n], 0, 0, 0); __builtin_amdgcn_s_setprio(0); } while (0)
#define PG8_WAIT_V(n) asm volatile("s_waitcnt vmcnt(" #n ")" ::: "memory")
#define PG8_WAIT_L(n) asm volatile("s_waitcnt lgkmcnt(" #n ")" ::: "memory")
#define PG8_BAR __builtin_amdgcn_s_barrier()
#define PG8_SCHED __builtin_amdgcn_sched_barrier(0)
#define PG8_GROWS(dst, slot) do { _Pragma("unroll") for (int _h = 0; _h < 2; ++_h) _Pragma("unroll") for (int _i = 0; _i < 2; ++_i) \
        dst[_h][_i] = (unsigned)rowtab[(slot) * 256 + _h * 128 + Rr[_i]] * (unsigned)(K * 2) + voffA[_i]; } while (0)
    Unit cur, nxt; int ui = 0;
    if (!S.next(0, cur)) return;
    f32x4 acc[2][2][4][2];
#pragma unroll
    for (int a = 0; a < 2; ++a)
#pragma unroll
        for (int b = 0; b < 2; ++b)
#pragma unroll
            for (int m = 0; m < 4; ++m)
#pragma unroll
                for (int n = 0; n < 2; ++n) acc[a][b][m][n] = (f32x4){0.f, 0.f, 0.f, 0.f};
    bf16x8 At[4][2], B0[2][2], B1[2][2];
    const char* const gA = (const char*)g.A;
    const char* cA = gA + (size_t)cur.pm * tstep; const char* cB = (const char*)g.Bt + (size_t)cur.pn * tstep;
    const char* nA = cA;
    unsigned gac[2][2], gan[2][2];
    if constexpr (GATHER) { PG8_GROWS(gac, 0); } else { gac[0][0] = gac[0][1] = gac[1][0] = gac[1][1] = 0u; }
#pragma unroll
    for (int h = 0; h < 2; ++h) { gan[h][0] = gac[h][0]; gan[h][1] = gac[h][1]; }
    PG8_STAGE(PG8_SB(0, 0), cB, voffB); PG8_STAGE(PG8_SB(0, 1), cB + hstep, voffB); PG8_STA(PG8_SA(0, 0), 0, 0, (size_t)0); PG8_STA(PG8_SA(0, 1), 0, 1, (size_t)0);
    if (wr == 1) PG8_BAR;
    PG8_WAIT_V(2); PG8_BAR;
    PG8_STAGE(PG8_SB(1, 0), cB + kstep, voffB); PG8_STA(PG8_SA(1, 0), 0, 0, kstep); PG8_STAGE(PG8_SB(1, 1), cB + hstep + kstep, voffB);
    PG8_WAIT_V(6); PG8_BAR;
    for (;;) {
        const bool has_next = S.next(ui + 1, nxt);
        nA = has_next ? gA + (size_t)nxt.pm * tstep : cA; const char* nB = has_next ? (const char*)g.Bt + (size_t)nxt.pn * tstep : cB;
        if constexpr (GATHER) { if (has_next) { PG8_GROWS(gan, ui + 1); } }
        for (int t = 0; t < nt; t += 2) {
            const bool last = (t == nt - 2);
            const size_t kb1 = (size_t)(t + 1) * kstep;
            const size_t kb2 = last ? (size_t)0 : (size_t)(t + 2) * kstep;
            const char* b2 = last ? nB : cB + (size_t)(t + 2) * kstep;
            const char* b3 = b2 + kstep;
            if constexpr (Epi::MIDSCALE) { if (t == nt / 2) E.midscale(acc, ui, wr, fr); }
            PG8_LDB(B0, 0, 0); PG8_LDB(B1, 0, 1); PG8_SCHED; PG8_LDA(At, 0, 0); PG8_STA(PG8_SA(1, 1), 0, 1, kb1);
            PG8_WAIT_V(8); PG8_WAIT_L(0); PG8_BAR; PG8_MMA(0, 0, At, B0); PG8_MMA(0, 1, At, B1); PG8_BAR; PG8_SCHED;
            PG8_LDA(At, 0, 1); PG8_STAGE(PG8_SB(0, 0), b2, voffB); PG8_STAGE(PG8_SB(0, 1), b2 + hstep, voffB); PG8_STA(PG8_SA(0, 0), last, 0, kb2);
            PG8_WAIT_V(8); PG8_WAIT_L(0); PG8_BAR; PG8_MMA(1, 0, At, B0); PG8_MMA(1, 1, At, B1); PG8_BAR; PG8_SCHED;
            PG8_LDB(B0, 1, 0); PG8_LDB(B1, 1, 1); PG8_SCHED; PG8_LDA(At, 1, 0); PG8_STA(PG8_SA(0, 1), last, 1, kb2);
            PG8_WAIT_V(8); PG8_WAIT_L(0); PG8_BAR; PG8_MMA(0, 0, At, B0); PG8_MMA(0, 1, At, B1); PG8_BAR; PG8_SCHED;
            PG8_LDA(At, 1, 1); PG8_STAGE(PG8_SB(1, 0), b3, voffB); PG8_STAGE(PG8_SB(1, 1), b3 + hstep, voffB); PG8_STA(PG8_SA(1, 0), last, 0, kb2 + kstep);
            PG8_WAIT_V(8); PG8_WAIT_L(0); PG8_BAR; PG8_MMA(1, 0, At, B0); PG8_MMA(1, 1, At, B1); PG8_BAR; PG8_SCHED;
        }
        if (wr == 0) PG8_BAR;
        E(acc, cur, ui, wr, wc, fr, fq);
        if (!has_next) break;
#pragma unroll
        for (int a = 0; a < 2; ++a)
#pragma unroll
            for (int b = 0; b < 2; ++b)
#pragma unroll
                for (int m = 0; m < 4; ++m)
#pragma unroll
                    for (int n = 0; n < 2; ++n) acc[a][b][m][n] = (f32x4){0.f, 0.f, 0.f, 0.f};
        cur = nxt; cA = nA; cB = nB; ++ui;
#pragma unroll
        for (int h = 0; h < 2; ++h) { gac[h][0] = gan[h][0]; gac[h][1] = gan[h][1]; }
        if (wr == 1) PG8_BAR;
    }
    PG8_WAIT_V(0);
    PG8_BAR;
#undef PG8_SA
#undef PG8_SB
#undef PG8_STAGE
#undef PG8_STA
#undef PG8_LDA
#undef PG8_LDB
#undef PG8_MMA
#undef PG8_WAIT_V
#undef PG8_WAIT_L
#undef PG8_BAR
#undef PG8_SCHED
#undef PG8_GROWS
}
}

constexpr int NWAVES = 8, NTHR = NWAVES * 64;
constexpr int SCR_BYTES = 148480;
constexpr int LCTL_OFF = SCR_BYTES;
constexpr int L_MISC = LCTL_OFF;
constexpr int L_PTILE = LCTL_OFF + 128;
constexpr int L_CNT = LCTL_OFF + 320;
constexpr int L_TAB = LCTL_OFF + 512;
constexpr int LDS_BYTES = 163840;
static_assert(L_TAB + 14336 <= LDS_BYTES, "LDS map");

#define GAS __attribute__((address_space(1)))
#define LAS __attribute__((address_space(3)))
typedef float f32x2v __attribute__((ext_vector_type(2)));
typedef unsigned v4u __attribute__((ext_vector_type(4)));
typedef unsigned v2u __attribute__((ext_vector_type(2)));
typedef short bf16x8 __attribute__((ext_vector_type(8)));
typedef _Float16 f16x8 __attribute__((ext_vector_type(8)));
typedef _Float16 f16x2 __attribute__((ext_vector_type(2)));
#define LDS_WAIT() asm volatile("s_waitcnt lgkmcnt(0)" ::: "memory")
#define VM_WAIT() asm volatile("s_waitcnt vmcnt(0)" ::: "memory")
typedef __bf16 bf16x2_hw __attribute__((ext_vector_type(2)));
__device__ __forceinline__ unsigned pk2(float lo, float hi) { const f32x2v v = {lo, hi}; const bf16x2_hw b = __builtin_convertvector(v, bf16x2_hw); return __builtin_bit_cast(unsigned, b); }
__device__ __forceinline__ float dpp_add(float v, const int ctrl_sel) {
    int x = __builtin_bit_cast(int, v), y;
    if (ctrl_sel == 0) y = __builtin_amdgcn_update_dpp(0, x, 0xB1, 0xf, 0xf, true);
    else if (ctrl_sel == 1) y = __builtin_amdgcn_update_dpp(0, x, 0x4E, 0xf, 0xf, true);
    else if (ctrl_sel == 2) y = __builtin_amdgcn_update_dpp(0, x, 0x141, 0xf, 0xf, true);
    else y = __builtin_amdgcn_update_dpp(0, x, 0x140, 0xf, 0xf, true);
    return v + __builtin_bit_cast(float, y);
}
__device__ __forceinline__ float row16_sum(float v) { v = dpp_add(v, 0); v = dpp_add(v, 1); v = dpp_add(v, 2); v = dpp_add(v, 3); return v; }
__device__ __forceinline__ float wave_sum(float v) {
    v = row16_sum(v);
    const int x = __builtin_bit_cast(int, v);
    const float r0 = __builtin_bit_cast(float, __builtin_amdgcn_readlane(x, 0)), r1 = __builtin_bit_cast(float, __builtin_amdgcn_readlane(x, 16));
    const float r2 = __builtin_bit_cast(float, __builtin_amdgcn_readlane(x, 32)), r3 = __builtin_bit_cast(float, __builtin_amdgcn_readlane(x, 48));
    return (r0 + r1) + (r2 + r3);
}
__device__ __forceinline__ float shfl_xor_fresh(float v, int mask) {
    int l = __builtin_amdgcn_mbcnt_hi(~0u, __builtin_amdgcn_mbcnt_lo(~0u, 0u)); asm volatile("" : "+v"(l));
    return __builtin_bit_cast(float, __builtin_amdgcn_ds_bpermute((l ^ mask) << 2, __builtin_bit_cast(int, v)));
}

#define XB_TMO      128
#define XB_XCNT(j)  (256  + 64 * (j))
#define XB_XSUB(j)  (1280 + 64 * (j))
#define XB_XGEN(j)  (2304 + 64 * (j))
#define XB_TOP      3328
#define XB_TOPGEN   3392
#define XCD_BAR_WORDS 3456
#define XB_SPIN_CAP (1u << 18)
__device__ __forceinline__ unsigned xb_ld(unsigned* p)              { return __hip_atomic_load(p, __ATOMIC_RELAXED, __HIP_MEMORY_SCOPE_AGENT); }
__device__ __forceinline__ unsigned xb_add(unsigned* p, unsigned v) { return __hip_atomic_fetch_add(p, v, __ATOMIC_RELAXED, __HIP_MEMORY_SCOPE_AGENT); }
__device__ __forceinline__ unsigned xb_xcc_id() { return (unsigned)__builtin_amdgcn_s_getreg((3 << 11) | 20) & 0xFu; }
#define XB_SPIN(cond, bar) do { unsigned _sp = 0; while (cond) { __builtin_amdgcn_s_sleep(1); \
    if ((++_sp & 255u) == 0u) { if (xb_ld(&(bar)[XB_TMO])) break; if (_sp > XB_SPIN_CAP) { atomicAdd(&(bar)[XB_TMO], 1u); break; } } } } while (0)
struct XcdBarrier { unsigned* bar; unsigned x; volatile LAS unsigned* st; int wv; };
__device__ __forceinline__ bool xb_thread0(int wv) { return wv == 0 && __builtin_amdgcn_mbcnt_hi(~0u, __builtin_amdgcn_mbcnt_lo(~0u, 0u)) == 0u; }
__device__ __forceinline__ XcdBarrier xcd_barrier_post(unsigned* bar, volatile LAS unsigned* st, int wv) {
    XcdBarrier b; b.bar = bar; b.x = xb_xcc_id(); b.st = st; b.wv = wv;
    if (xb_thread0(wv)) (void)xb_add(&bar[XB_XCNT(b.x)], 1u);
    return b;
}
__device__ __forceinline__ void xcd_barrier_complete(unsigned* bar, unsigned x, unsigned& nloc, unsigned& nx) {
    const unsigned G = gridDim.x * gridDim.y * gridDim.z;
    unsigned sum, cnt, mine, sp = 0u;
    for (;;) {
        sum = 0u; cnt = 0u; mine = 0u;
#pragma unroll
        for (unsigned j = 0; j < 16; ++j) { const unsigned c = xb_ld(&bar[XB_XCNT(j)]); sum += c; cnt += (c > 0u) ? 1u : 0u; mine = (j == x) ? c : mine; }
        if (sum == G) break;
        __builtin_amdgcn_s_sleep(1);
        if ((++sp & 255u) == 0u) { if (xb_ld(&bar[XB_TMO])) break; if (sp > XB_SPIN_CAP) { atomicAdd(&bar[XB_TMO], 1u); break; } }
    }
    nloc = mine > 0u ? mine : 1u; nx = cnt > 0u ? cnt : 1u;
}
__device__ __forceinline__ void xcd_barrier(const XcdBarrier& b) {
    asm volatile("s_waitcnt vmcnt(0)" ::: "memory");
    __syncthreads();
    if (xb_thread0(b.wv)) {
        unsigned* bar = b.bar;
        __builtin_amdgcn_s_waitcnt(0);
        unsigned nloc = b.st[0], nx = b.st[1];
        if (nloc == 0u) { xcd_barrier_complete(bar, b.x, nloc, nx); b.st[0] = nloc; b.st[1] = nx; }
        const unsigned old = xb_add(&bar[XB_XSUB(b.x)], 1u);
        const unsigned gen = old / nloc;
        if (old + 1u == (gen + 1u) * nloc) {
            __builtin_amdgcn_fence(__ATOMIC_RELEASE, "agent");
            asm volatile("s_waitcnt vmcnt(0)" ::: "memory");
            const unsigned og = xb_add(&bar[XB_TOP], 1u);
            const unsigned tg = og / nx;
            if (og + 1u == (tg + 1u) * nx) xb_add(&bar[XB_TOPGEN], 1u);
            else XB_SPIN(xb_ld(&bar[XB_TOPGEN]) == tg, bar);
            __builtin_amdgcn_fence(__ATOMIC_ACQUIRE, "agent");
            xb_add(&bar[XB_XGEN(b.x)], 1u);
            asm volatile("s_waitcnt vmcnt(0)" ::: "memory");
        } else {
            XB_SPIN(xb_ld(&bar[XB_XGEN(b.x)]) == gen, bar);
            __builtin_amdgcn_fence(__ATOMIC_ACQUIRE, "agent");
            asm volatile("s_waitcnt vmcnt(0)" ::: "memory");
        }
    }
    __syncthreads();
}
constexpr int CW_HMC = 32768, CW_TMO = 2048;   static_assert(CW_TMO == 2048, "MoeOrder2 uses the literal");
#ifndef MOE2_PRE
#define MOE2_PRE 4
#endif
constexpr int CW_BAR = 4096;
static_assert((CW_BAR + XCD_BAR_WORDS) * 4 <= (int)CTL_BYTES, "ctl words");

using pg8::f32x4; using pg8::Unit;
struct EpiIn {
    static constexpr bool PERM = true, MIDSCALE = false;
    bf16* Z; bf16* U; bf16* SG;
    __device__ __forceinline__ void operator()(const f32x4 (&acc)[2][2][4][2], const Unit& u, int, int wr, int wc, int fr, int fq) const {
        const int row0 = u.pm * 256 + wr * 64 + fr, cb = (u.pn & 7) * 128 + wc * 32 + 8 * fq;
#pragma unroll
        for (int ai = 0; ai < 2; ++ai)
#pragma unroll
            for (int m = 0; m < 4; ++m) {
                const int row = row0 + ai * 128 + m * 16;
                float v[8], s[8];
#pragma unroll
                for (int n = 0; n < 2; ++n)
#pragma unroll
                    for (int j = 0; j < 4; ++j) { v[n * 4 + j] = acc[ai][0][m][n][j]; s[n * 4 + j] = sigmoidf_(acc[ai][1][m][n][j]); }
                if (u.pn < 8) {
                    v4u w; w.x = pk2(v[0] * s[0], v[1] * s[1]); w.y = pk2(v[2] * s[2], v[3] * s[3]); w.z = pk2(v[4] * s[4], v[5] * s[5]); w.w = pk2(v[6] * s[6], v[7] * s[7]);
                    *(v4u*)(Z + (size_t)row * CCH + cb) = w;
                } else {
                    const int b = row >> 11, t = row & (SEQ - 1), g = cb >> 4, h0 = cb & 15;
                    const size_t o = (((size_t)b * NG + g) * SEQ + t) * GW + h0;
                    v4u w; w.x = pk2(v[0], v[1]); w.y = pk2(v[2], v[3]); w.z = pk2(v[4], v[5]); w.w = pk2(v[6], v[7]);
                    v4u q; q.x = pk2(s[0], s[1]); q.y = pk2(s[2], s[3]); q.z = pk2(s[4], s[5]); q.w = pk2(s[6], s[7]);
                    *(v4u*)(U + o) = w; *(v4u*)(SG + o) = q;
                }
            }
    }
};
struct EpiOut {
    static constexpr bool PERM = true, MIDSCALE = true;
    bf16* xb; const float* gate1;
    const LAS float* rs;
    __device__ __forceinline__ void midscale(f32x4 (&acc)[2][2][4][2], int ui, int wr, int fr) const {
#pragma unroll
        for (int ai = 0; ai < 2; ++ai)
#pragma unroll
            for (int m = 0; m < 4; ++m) { const float r = rs[ui * 256 + ai * 128 + wr * 64 + m * 16 + fr];
#pragma unroll
                for (int bj = 0; bj < 2; ++bj)
#pragma unroll
                    for (int n = 0; n < 2; ++n) acc[ai][bj][m][n] *= r; }
    }
    __device__ __forceinline__ void operator()(const f32x4 (&acc)[2][2][4][2], const Unit& u, int, int wr, int wc, int fr, int fq) const {
        const int row0 = u.pm * 256 + wr * 64 + fr, col0 = u.pn * 256 + wc * 32 + 8 * fq;
        const float* g1 = gate1 + (size_t)(row0 >> 11) * 6 * D + col0;
        f32x4 gv[2][2];
#pragma unroll
        for (int bj = 0; bj < 2; ++bj)
#pragma unroll
            for (int n = 0; n < 2; ++n) gv[bj][n] = *(const f32x4*)(g1 + bj * 128 + n * 4);
#pragma unroll
        for (int ai = 0; ai < 2; ++ai) {
            v4u xv[4][2];
#pragma unroll
            for (int m = 0; m < 4; ++m) { const bf16* rp = xb + (size_t)(row0 + ai * 128 + m * 16) * D + col0; xv[m][0] = *(const v4u*)rp; xv[m][1] = *(const v4u*)(rp + 128); }
            __builtin_amdgcn_sched_barrier(0);
#pragma unroll
            for (int m = 0; m < 4; ++m) { bf16* rp = xb + (size_t)(row0 + ai * 128 + m * 16) * D + col0;
#pragma unroll
                for (int bj = 0; bj < 2; ++bj) { const f32x4 a0 = gv[bj][0] * acc[ai][bj][m][0], a1 = gv[bj][1] * acc[ai][bj][m][1]; const v4u x = xv[m][bj];
                    v4u o; o.x = pk2(__uint_as_float(x.x << 16) + a0[0], __uint_as_float(x.x & 0xffff0000u) + a0[1]); o.y = pk2(__uint_as_float(x.y << 16) + a0[2], __uint_as_float(x.y & 0xffff0000u) + a0[3]);
                    o.z = pk2(__uint_as_float(x.z << 16) + a1[0], __uint_as_float(x.z & 0xffff0000u) + a1[1]); o.w = pk2(__uint_as_float(x.w << 16) + a1[2], __uint_as_float(x.w & 0xffff0000u) + a1[3]);
                    *(v4u*)(rp + bj * 128) = o; } }
            __builtin_amdgcn_sched_barrier(0);
        }
    }
};
struct EpiMoe1 {
    static constexpr bool PERM = true, MIDSCALE = false;
    bf16* HM; int hoff;
    __device__ __forceinline__ void operator()(const f32x4 (&acc)[2][2][4][2], const Unit& u, int, int wr, int wc, int fr, int fq) const {
        const int row0 = u.pm * 256 + wr * 64 + fr, cb = (u.pn & 3) * 128 + wc * 32 + 8 * fq;
#pragma unroll
        for (int ai = 0; ai < 2; ++ai)
#pragma unroll
            for (int m = 0; m < 4; ++m) {
                float v[8];
#pragma unroll
                for (int n = 0; n < 2; ++n)
#pragma unroll
                    for (int j = 0; j < 4; ++j) v[n * 4 + j] = siluf_(acc[ai][0][m][n][j]) * acc[ai][1][m][n][j];
                v4u w; w.x = pk2(v[0], v[1]); w.y = pk2(v[2], v[3]); w.z = pk2(v[4], v[5]); w.w = pk2(v[6], v[7]);
                bf16* p = HM + (size_t)(row0 + ai * 128 + m * 16) * FF + cb;
                asm volatile("global_store_dwordx4 %0, %1, off sc1\n\ts_nop 3" :: "v"(p), "v"(w) : "memory");
            }
        asm volatile("s_waitcnt vmcnt(0)" ::: "memory");
        if ((fr | fq) == 0) (void)__hip_atomic_fetch_add(ctl_words() + hoff + 64 * u.pm, 1u, __ATOMIC_RELAXED, __HIP_MEMORY_SCOPE_AGENT);
    }
};
struct EpiMoe2 {
    static constexpr bool PERM = true, MIDSCALE = false;
    bf16* Y; const LAS unsigned* ent; const LAS float* wt;
    __device__ __forceinline__ void operator()(const f32x4 (&acc)[2][2][4][2], const Unit& u, int ui, int wr, int wc, int fr, int fq) const {
        const int cb = (u.pn & 7) * 256 + wc * 32 + 8 * fq;
#pragma unroll
        for (int ai = 0; ai < 2; ++ai)
#pragma unroll
            for (int m = 0; m < 4; ++m) {
                const int rl = ui * 256 + ai * 128 + wr * 64 + m * 16 + fr;
                const unsigned en = ent[rl]; const float w = wt[rl];
                if (en != ~0u) {
                    bf16* yr = Y + ((size_t)(en & 1u) * T + (en >> 1)) * D + cb;
#pragma unroll
                    for (int bj = 0; bj < 2; ++bj) { const f32x4 a0 = acc[ai][bj][m][0] * w, a1 = acc[ai][bj][m][1] * w;
                        v4u o; o.x = pk2(a0[0], a0[1]); o.y = pk2(a0[2], a0[3]); o.z = pk2(a1[0], a1[1]); o.w = pk2(a1[2], a1[3]);
                        *(v4u*)(yr + bj * 128) = o; }
                }
            }
    }
};

struct Frame {
    LAS unsigned char* lds;
    int vcu, G, wv;
};
__device__ __forceinline__ int fresh_tid(int wv) { int t = wv * 64 + (int)__builtin_amdgcn_mbcnt_hi(~0u, __builtin_amdgcn_mbcnt_lo(~0u, 0u)); asm volatile("" : "+v"(t)); return t; }
__device__ __forceinline__ int fresh_wave(int wv) { asm volatile("" : "+s"(wv)); return wv; }
#define PHASE_IDS const int wave = fresh_wave(F.wv), tid = fresh_tid(wave), lane = tid & 63; (void)lane
typedef __attribute__((address_space(4))) const Ptrs* KPtr;
__device__ __forceinline__ KPtr kp() { KPtr a = (KPtr)__builtin_amdgcn_kernarg_segment_ptr(); asm volatile("" : "+s"(a)); return a; }
#define KP (kp())
__device__ __forceinline__ unsigned* ctl_words() { return (unsigned*)(KP->ws + WS_CTL); }

struct P0Tile { const float* src; bf16* dst; int ld, K; };
__device__ __forceinline__ void p0_load(const P0Tile& t, f32x4 (&v)[16], int lane) {
    const float* s = t.src + (size_t)(16 * (lane >> 4)) * t.ld + 4 * (lane & 15);
#pragma unroll
    for (int i = 0; i < 16; ++i) v[i] = __builtin_nontemporal_load((const f32x4*)(s + (size_t)i * t.ld));
}
__device__ __forceinline__ void p0_store(const P0Tile& t, const f32x4 (&v)[16], LAS unsigned char* scr, int lane) {
#pragma unroll
    for (int j = 0; j < 4; ++j) {
        v4u a, b2;
        a.x = pk2(v[0][j], v[1][j]); a.y = pk2(v[2][j], v[3][j]); a.z = pk2(v[4][j], v[5][j]); a.w = pk2(v[6][j], v[7][j]);
        b2.x = pk2(v[8][j], v[9][j]); b2.y = pk2(v[10][j], v[11][j]); b2.z = pk2(v[12][j], v[13][j]); b2.w = pk2(v[14][j], v[15][j]);
        LAS unsigned char* r = scr + (4 * (lane & 15) + j) * 144 + 32 * (lane >> 4);
        *(LAS v4u*)r = a; *(LAS v4u*)(r + 16) = b2;
    }
    LDS_WAIT(); asm volatile("" ::: "memory");
#pragma unroll
    for (int q = 0; q < 8; ++q) { const int n = 8 * q + (lane >> 3); const v4u o = *(const LAS v4u*)(scr + n * 144 + 16 * (lane & 7));
        __builtin_nontemporal_store(o, (v4u*)(t.dst + (size_t)n * t.K + 8 * (lane & 7))); }
    LDS_WAIT(); asm volatile("" ::: "memory");
}
constexpr int P0_IT_WIN = NL * (INC / 64) * (D / 64);
constexpr int P0_IT_WOUT = NL * (D / 64) * (D / 64);
constexpr int P0_IT_GU = NL * NE * (2 * FF / 64) * (D / 64);
constexpr int P0_IT_DN = NL * NE * (D / 64) * (FF / 64);
constexpr int P0_ITEMS = P0_IT_WIN + P0_IT_WOUT + P0_IT_GU + P0_IT_DN;
__device__ __forceinline__ void p0_nbkb(int r, int KBt, int& nb, int& kb) { nb = r / KBt; kb = r % KBt; }
__device__ __forceinline__ P0Tile p0_tile_of(int it) {
    unsigned char* ws = KP->ws; P0Tile t; int nb, kb;
    if (it < P0_IT_WIN) {
        const int l = it / (P0_IT_WIN / NL), r = it % (P0_IT_WIN / NL); p0_nbkb(r, D / 64, nb, kb);
        const int n0 = nb * 64, pn = n0 >> 8, w = n0 & 255, half = w >> 7, j = w & 127;
        const int sc = (pn < 8 ? 0 : 2048) + half * 1024 + (pn & 7) * 128 + j;
        t.src = KP->w_in + (size_t)l * D * INC + (size_t)(kb * 64) * INC + sc; t.ld = INC; t.dst = (bf16*)(ws + WS_WIN) + ((size_t)l * INC + n0) * D + kb * 64; t.K = D;
        return t;
    }
    it -= P0_IT_WIN;
    if (it < P0_IT_WOUT) {
        const int l = it / (P0_IT_WOUT / NL), r = it % (P0_IT_WOUT / NL); p0_nbkb(r, D / 64, nb, kb);
        const int k0 = kb * 64, sk = (k0 < SCH) ? k0 + CCH : k0 - SCH;
        t.src = KP->w_out + (size_t)l * D * D + (size_t)sk * D + nb * 64; t.ld = D; t.dst = (bf16*)(ws + WS_WOUT) + ((size_t)l * D + nb * 64) * D + k0; t.K = D;
        return t;
    }
    it -= P0_IT_WOUT;
    if (it < P0_IT_GU) {
        const int le = it / 512, r = it % 512; p0_nbkb(r, D / 64, nb, kb);
        const int n0 = nb * 64, pn = n0 >> 8, w = n0 & 255, half = w >> 7, j = w & 127, f0 = pn * 128 + j;
        t.src = (half ? KP->w_up : KP->w_gate) + (size_t)le * D * FF + (size_t)(kb * 64) * FF + f0; t.ld = FF; t.dst = (bf16*)(ws + WS_GU) + ((size_t)le * 2 * FF + n0) * D + kb * 64; t.K = D;
        return t;
    }
    it -= P0_IT_GU;
    {
        const int le = it / 256, r = it % 256; p0_nbkb(r, FF / 64, nb, kb);
        t.src = KP->w_down + (size_t)le * FF * D + (size_t)(kb * 64) * D + nb * 64; t.ld = D; t.dst = (bf16*)(ws + WS_DN) + ((size_t)le * D + nb * 64) * FF + kb * 64; t.K = FF;
    }
    return t;
}
__device__ __forceinline__ void p0_mod_item(Frame& F, int item) {
    PHASE_IDS;
    const int l = item / 96, cbk = item % 96, col = cbk * 128 + 2 * lane;
    LAS float* ca = (LAS float*)F.lds;
    LAS float* red = (LAS float*)(F.lds + 65536);
    for (int i = tid; i < NB * D; i += NTHR) { const int b = i / D, k = i % D; ca[k * 8 + b] = siluf_(KP->c[i]); }
    __syncthreads();
    float a0[8], a1[8];
#pragma unroll
    for (int b = 0; b < 8; ++b) { a0[b] = 0.f; a1[b] = 0.f; }
    const float* w = KP->w_ada + (size_t)l * D * 6 * D + (size_t)(wave * 256) * 6 * D + col;
#pragma unroll 32
    for (int k = 0; k < 256; ++k) {
        const f32x2v wv_ = __builtin_nontemporal_load((const f32x2v*)(w + (size_t)k * 6 * D)); const float2 wv = {wv_.x, wv_.y};
        const f32x4 c0 = *(const LAS f32x4*)(ca + (wave * 256 + k) * 8), c1 = *(const LAS f32x4*)(ca + (wave * 256 + k) * 8 + 4);
#pragma unroll
        for (int b = 0; b < 4; ++b) { a0[b] += c0[b] * wv.x; a1[b] += c0[b] * wv.y; a0[4 + b] += c1[b] * wv.x; a1[4 + b] += c1[b] * wv.y; }
    }
#pragma unroll
    for (int b = 0; b < 8; ++b) { red[(wave * 8 + b) * 128 + 2 * lane] = a0[b]; red[(wave * 8 + b) * 128 + 2 * lane + 1] = a1[b]; }
    __syncthreads();
    for (int o = tid; o < 8 * 128; o += NTHR) { const int b = o >> 7, cc = o & 127; float s = KP->b_ada[l * 6 * D + cbk * 128 + cc];
#pragma unroll
        for (int wv = 0; wv < 8; ++wv) s += red[(wv * 8 + b) * 128 + cc];
        ((float*)(KP->ws + WS_MOD))[((size_t)l * NB + b) * 6 * D + cbk * 128 + cc] = s; }
    __syncthreads();
}
constexpr int RW_FRAGS = NL * 64 * 3;
__device__ __forceinline__ void p0_router_frag(Frame& F, int fi, int lane);
__device__ __forceinline__ void p0_ssm_mats(Frame& F, int lg);
constexpr int P0_FIRST = P0_IT_WIN / NL;
constexpr int CW_P0Q = 1536;
constexpr int G1_SPLIT = 160;
__device__ __forceinline__ void p0_prologue(Frame& F) {
    if ((int)blockIdx.x < 192) p0_mod_item(F, blockIdx.x);
    for (int lg = F.G - 1 - (int)blockIdx.x; lg < NL * NG; lg += F.G) p0_ssm_mats(F, lg);
    PHASE_IDS;
    LAS unsigned char* scr = F.lds + wave * 9216;
    const int gw = F.vcu * NWAVES + wave, NGW = F.G * NWAVES;
#pragma unroll 1
    for (int it = gw; it < P0_FIRST; it += NGW) { f32x4 va[16]; const P0Tile ta = p0_tile_of(it); p0_load(ta, va, lane); p0_store(ta, va, scr, lane); }
    for (int fi = gw; fi < RW_FRAGS; fi += NGW) p0_router_frag(F, fi, lane);
}
__device__ __forceinline__ void p0_queue(Frame& F) {
    PHASE_IDS;
    LAS unsigned char* scr = F.lds + wave * 9216;
    unsigned* cur = ctl_words() + CW_P0Q;
#pragma unroll 1
    for (;;) {
        unsigned q = 0u;
        if (lane == 0) q = __hip_atomic_fetch_add(cur, 4u, __ATOMIC_RELAXED, __HIP_MEMORY_SCOPE_AGENT);
        const int it0 = P0_FIRST + (int)__builtin_amdgcn_readfirstlane(q);
        if (it0 >= P0_ITEMS) break;
#pragma unroll 1
        for (int it = it0; it < it0 + 4 && it < P0_ITEMS; ++it) { f32x4 va[16]; const P0Tile ta = p0_tile_of(it); p0_load(ta, va, lane); p0_store(ta, va, scr, lane); }
    }
    __syncthreads();
}


template <int MODE  , bool has_y>
__device__ __forceinline__ void pn_rows(Frame& F, int l, const float* xin, int lp) {
    unsigned char* ws = KP->ws;
    const float* mod = (const float*)(ws + WS_MOD);
    PHASE_IDS;
    const int row0 = F.vcu * 64 + wave * 8, b = (F.vcu * 64) >> 11;
    LAS f32x4* Lg = (LAS f32x4*)F.lds;
    LAS f32x4* Lsh = Lg + 512;
    LAS f32x4* Lg2 = Lg + 1024;
    {
        const int i = tid;
        if (MODE == 0) { const f32x4 g = ((const f32x4*)(KP->norm1_g + l * D))[i]; const f32x4* sh = (const f32x4*)(mod + ((size_t)l * NB + b) * 6 * D); Lg[i] = g * (1.f + sh[D / 4 + i]); Lsh[i] = sh[i]; }
        else Lg[i] = ((const f32x4*)KP->final_g)[i];
        if (has_y) Lg2[i] = ((const f32x4*)(mod + ((size_t)lp * NB + b) * 6 * D + 5 * D))[i];
    }
    __syncthreads();
    f32x4 xa[has_y ? 1 : 8], xb[has_y ? 1 : 8]; v2u ra[has_y ? 8 : 1], rb[has_y ? 8 : 1], ya0[has_y ? 8 : 1], ya1[has_y ? 8 : 1], yb0[has_y ? 8 : 1], yb1[has_y ? 8 : 1], da[1], db[1];
#define PN_LOAD(XF, XR, Y0, Y1, DD, row) do { \
        if constexpr (!has_y) { const f32x4* xr_ = (const f32x4*)(xin + (size_t)(row) * D) + lane; _Pragma("unroll") for (int j = 0; j < 8; ++j) XF[j] = __builtin_nontemporal_load(xr_ + 64 * j); } \
        else { const v2u* x_ = (const v2u*)((const bf16*)(ws + WS_XB) + (size_t)(row) * D) + lane; const v2u* y0_ = (const v2u*)((const bf16*)(ws + WS_Y) + (size_t)(row) * D) + lane; const v2u* y1_ = (const v2u*)((const bf16*)(ws + WS_Y) + ((size_t)T + (row)) * D) + lane; \
            _Pragma("unroll") for (int j = 0; j < 8; ++j) { XR[j] = __builtin_nontemporal_load(x_ + 64 * j); Y0[j] = __builtin_nontemporal_load(y0_ + 64 * j); Y1[j] = __builtin_nontemporal_load(y1_ + 64 * j); } } } while (0)
#define PN_PROC(XF, XR, Y0, Y1, DD, row) do { f32x4 X[8]; \
        if constexpr (!has_y) { _Pragma("unroll") for (int j = 0; j < 8; ++j) X[j] = XF[j]; } \
        else { _Pragma("unroll") for (int j = 0; j < 8; ++j) { const v2u x = XR[j], a = Y0[j], c = Y1[j]; const f32x4 g = Lg2[64 * j + lane]; \
            X[j][0] = __uint_as_float(x.x << 16) + g[0] * (__uint_as_float(a.x << 16) + __uint_as_float(c.x << 16)); X[j][1] = __uint_as_float(x.x & 0xffff0000u) + g[1] * (__uint_as_float(a.x & 0xffff0000u) + __uint_as_float(c.x & 0xffff0000u)); \
            X[j][2] = __uint_as_float(x.y << 16) + g[2] * (__uint_as_float(a.y << 16) + __uint_as_float(c.y << 16)); X[j][3] = __uint_as_float(x.y & 0xffff0000u) + g[3] * (__uint_as_float(a.y & 0xffff0000u) + __uint_as_float(c.y & 0xffff0000u)); } } \
        __builtin_amdgcn_sched_barrier(0); \
        if (MODE == 0) { v2u* xo_ = (v2u*)((bf16*)(ws + WS_XB) + (size_t)(row) * D) + lane; _Pragma("unroll") for (int j = 0; j < 8; ++j) { v2u o; o.x = pk2(X[j][0], X[j][1]); o.y = pk2(X[j][2], X[j][3]); __builtin_nontemporal_store(o, xo_ + 64 * j); } } \
        float ss_ = 0.f; _Pragma("unroll") for (int j = 0; j < 8; ++j) ss_ += (X[j][0] * X[j][0] + X[j][1] * X[j][1]) + (X[j][2] * X[j][2] + X[j][3] * X[j][3]); \
        const float rstd_ = 1.f / sqrtf(wave_sum(ss_) * (1.f / D) + EPS); \
        __builtin_amdgcn_sched_barrier(0); \
        if (MODE == 2) { f32x4* o_ = (f32x4*)(KP->out + (size_t)(row) * D) + lane; _Pragma("unroll") for (int j = 0; j < 8; ++j) __builtin_nontemporal_store(X[j] * rstd_ * Lg[64 * j + lane], o_ + 64 * j); } \
        else { v2u* H_ = (v2u*)((bf16*)(ws + WS_H) + (size_t)(row) * D) + lane; \
            _Pragma("unroll") for (int j = 0; j < 8; ++j) { const f32x4 h = X[j] * rstd_ * Lg[64 * j + lane] + Lsh[64 * j + lane]; v2u o; o.x = pk2(h[0], h[1]); o.y = pk2(h[2], h[3]); H_[64 * j] = o; } } } while (0)
    PN_LOAD(xa, ra, ya0, ya1, da, row0);
#pragma unroll 1
    for (int r = 0; r < 8; r += 2) {
        PN_LOAD(xb, rb, yb0, yb1, db, row0 + r + 1); __builtin_amdgcn_sched_barrier(0);
        PN_PROC(xa, ra, ya0, ya1, da, row0 + r); __builtin_amdgcn_sched_barrier(0);
        if (r + 2 < 8) PN_LOAD(xa, ra, ya0, ya1, da, row0 + r + 2);
        __builtin_amdgcn_sched_barrier(0);
        PN_PROC(xb, rb, yb0, yb1, db, row0 + r + 1); __builtin_amdgcn_sched_barrier(0);
    }
#undef PN_LOAD
#undef PN_PROC
    __syncthreads();
}

__device__ __forceinline__ void p0_router_frag(Frame& F, int fi, int lane) {
    const int l = fi / 192, r = fi % 192, ks = r / 3, cb = r % 3;
    const int col = cb * 16 + (lane & 15), k0 = ks * 32 + 8 * (lane >> 4);
    f16x8 h;
#pragma unroll
    for (int q = 0; q < 8; ++q) { const int k = k0 + q;
        const float w = (col < 4) ? KP->rg_w[((size_t)l * D + k) * NGR + col] : (col < 36) ? KP->re_w[(((size_t)l * NGR + ((col - 4) >> 3)) * D + k) * EPG + ((col - 4) & 7)] : 0.f;
        h[q] = (_Float16)w; }
    ((v4u*)(KP->ws + WS_RW))[(size_t)fi * 64 + lane] = __builtin_bit_cast(v4u, h);
}

constexpr int PN2_TS = 2052;
__device__ __forceinline__ void pn2_phase(Frame& F, int l, bool commit) {
    unsigned char* ws = KP->ws;
    const float* mod = (const float*)(ws + WS_MOD);
    PHASE_IDS;
    LAS float* tile = (LAS float*)F.lds;
    LAS f32x4* Lg = (LAS f32x4*)(F.lds + 16 * PN2_TS * 4);
    LAS f32x4* Lsh = Lg + 512;
    LAS int* lcnt = (LAS int*)(F.lds + L_CNT);
    LAS int* lbase = (LAS int*)(F.lds + L_PTILE);
    LAS int* ent = (LAS int*)(F.lds + L_TAB);
    const int rowbase = F.vcu * 64;
    LAS float* rbias = (LAS float*)(F.lds + 16 * PN2_TS * 4 + 16384);
    v2u xa[2][8], xb[2][8];
#define PN2_LOAD(blk_, p_) do { const int ln_ = fresh_tid(F.wv) & 63; const v2u* xr_ = (const v2u*)((const bf16*)(ws + WS_XB) + (size_t)(rowbase + (blk_) * 16 + 2 * wave) * D) + ln_; \
        _Pragma("unroll") for (int j = 0; j < 8; ++j) { xa[p_][j] = __builtin_nontemporal_load(xr_ + 64 * j); xb[p_][j] = __builtin_nontemporal_load(xr_ + D / 4 + 64 * j); } } while (0)
#define PN2_ROW(XR, r_) do { f32x4 X[8]; _Pragma("unroll") for (int j = 0; j < 8; ++j) { const v2u x = XR[j]; X[j][0] = __uint_as_float(x.x << 16); X[j][1] = __uint_as_float(x.x & 0xffff0000u); X[j][2] = __uint_as_float(x.y << 16); X[j][3] = __uint_as_float(x.y & 0xffff0000u); } \
        float ss_ = 0.f; _Pragma("unroll") for (int j = 0; j < 8; ++j) ss_ += (X[j][0] * X[j][0] + X[j][1] * X[j][1]) + (X[j][2] * X[j][2] + X[j][3] * X[j][3]); \
        const float rstd_ = 1.f / sqrtf(wave_sum(ss_) * (1.f / D) + EPS); v2u* H_ = (v2u*)((bf16*)(ws + WS_H) + (size_t)(rowbase + blk * 16 + (r_)) * D) + lane; \
        _Pragma("unroll") for (int j = 0; j < 8; ++j) { const f32x4 h = X[j] * rstd_ * Lg[64 * j + lane] + Lsh[64 * j + lane]; v2u o; o.x = pk2(h[0], h[1]); o.y = pk2(h[2], h[3]); H_[64 * j] = o; \
            *(LAS f32x4*)(tile + (r_) * PN2_TS + 256 * j + 4 * lane) = h; } } while (0)
    PN2_LOAD(0, 0); PN2_LOAD(1, 1);
    v4u bw[8][3];
    {   const v4u* rw = (const v4u*)(ws + WS_RW) + ((size_t)l * 192 + (size_t)(wave * 8) * 3) * 64 + lane;
#pragma unroll
        for (int q = 0; q < 8; ++q)
#pragma unroll
            for (int cb = 0; cb < 3; ++cb) bw[q][cb] = rw[(size_t)(q * 3 + cb) * 64]; }
    {
        const int b = rowbase >> 11; const f32x4 g = ((const f32x4*)(KP->norm2_g + l * D))[tid]; const f32x4* sh = (const f32x4*)(mod + ((size_t)l * NB + b) * 6 * D + 3 * D);
        Lg[tid] = g * (1.f + sh[D / 4 + tid]); Lsh[tid] = sh[tid];
        if (tid < NE) lcnt[tid] = 0;
        if (tid < 36) rbias[tid] = (tid < 4) ? KP->rg_b[l * NGR + tid] : KP->re_b[l * NGR * EPG + tid - 4];
    }
    __syncthreads();
#pragma unroll
    for (int blk = 0; blk < 4; ++blk) {
        PN2_ROW(xa[blk & 1], 2 * wave); __builtin_amdgcn_sched_barrier(0);
        PN2_ROW(xb[blk & 1], 2 * wave + 1);
        __builtin_amdgcn_sched_barrier(0);
        if (blk + 2 < 4) PN2_LOAD(blk + 2, blk & 1);
        __builtin_amdgcn_sched_barrier(0);
        __syncthreads();
        f32x4 acc[3];
#pragma unroll
        for (int cb = 0; cb < 3; ++cb) acc[cb] = (f32x4){0.f, 0.f, 0.f, 0.f};
#pragma unroll
        for (int q = 0; q < 8; ++q) {
            const LAS float* tp = tile + (lane & 15) * PN2_TS + (wave * 8 + q) * 32 + 8 * (lane >> 4);
            const f32x4 x0 = *(const LAS f32x4*)tp, x1 = *(const LAS f32x4*)(tp + 4);
            f16x8 a_hi, a_lo;
            { const float xs[8] = {x0[0], x0[1], x0[2], x0[3], x1[0], x1[1], x1[2], x1[3]};
#pragma unroll
              for (int jj = 0; jj < 4; ++jj) { const f16x2 hp = __builtin_bit_cast(f16x2, __builtin_amdgcn_cvt_pkrtz(xs[2 * jj], xs[2 * jj + 1]));
                  const f16x2 lp = __builtin_bit_cast(f16x2, __builtin_amdgcn_cvt_pkrtz(xs[2 * jj] - (float)hp[0], xs[2 * jj + 1] - (float)hp[1]));
                  a_hi[2 * jj] = hp[0]; a_hi[2 * jj + 1] = hp[1]; a_lo[2 * jj] = lp[0]; a_lo[2 * jj + 1] = lp[1]; } }
#pragma unroll
            for (int cb = 0; cb < 3; ++cb) { const f16x8 b = __builtin_bit_cast(f16x8, bw[q][cb]);
                acc[cb] = __builtin_amdgcn_mfma_f32_16x16x32_f16(a_hi, b, acc[cb], 0, 0, 0);
                acc[cb] = __builtin_amdgcn_mfma_f32_16x16x32_f16(a_lo, b, acc[cb], 0, 0, 0); }
        }
        __builtin_amdgcn_sched_barrier(0);
        __syncthreads();
        LAS f32x4* part = (LAS f32x4*)F.lds;
#pragma unroll
        for (int cb = 0; cb < 3; ++cb) part[(wave * 3 + cb) * 64 + lane] = acc[cb];
        __syncthreads();
        LAS float* lg = (LAS float*)(F.lds + 32768);
        for (int o = tid; o < 16 * 36; o += NTHR) { const int row = o / 36, col = o % 36, cb = col >> 4, ln = (row >> 2) * 16 + (col & 15); float s = 0.f;
#pragma unroll
            for (int w = 0; w < 8; ++w) s += ((const LAS float*)(part + (w * 3 + cb) * 64 + ln))[row & 3];
            lg[o] = s; }
        __syncthreads();
        if (tid < 16) {
            const int row = rowbase + blk * 16 + tid; const LAS float* q = lg + tid * 36;
            float gl[4]; int gi = 0;
#pragma unroll
            for (int n = 0; n < 4; ++n) gl[n] = q[n] + rbias[n];
#pragma unroll
            for (int n = 1; n < 4; ++n) if (gl[n] > gl[gi]) gi = n;
            float den = 0.f;
#pragma unroll
            for (int n = 0; n < 4; ++n) den += expf(gl[n] - gl[gi]);
            const float gw = 1.f / den;
            float el[8];
#pragma unroll
            for (int e = 0; e < 8; ++e) el[e] = q[4 + gi * 8 + e] + rbias[4 + gi * 8 + e];
            int i1 = 0;
#pragma unroll
            for (int e = 1; e < 8; ++e) if (el[e] > el[i1]) i1 = e;
            int i2 = (i1 == 0) ? 1 : 0;
#pragma unroll
            for (int e = 0; e < 8; ++e) if (e != i1 && el[e] > el[i2]) i2 = e;
            const float e2 = expf(el[i2] - el[i1]); const float w1 = gw / (1.f + e2), w2 = gw * e2 / (1.f + e2);
            float* tw = (float*)(ws + WS_TOKW);
            *(f32x2v*)(tw + row * 2) = (f32x2v){w1, w2};
            const int ea = gi * 8 + i1, eb = gi * 8 + i2;
            const int ra = atomicAdd((int*)(lcnt + ea), 1), rb = atomicAdd((int*)(lcnt + eb), 1);
            LAS int* en = ent + (blk * 32 + 2 * tid) * 3;
            en[0] = ea; en[1] = row * 2; en[2] = ra; en[3] = eb; en[4] = row * 2 + 1; en[5] = rb;
        }
        __syncthreads();
    }
#undef PN2_LOAD
#undef PN2_ROW
    if (commit) {
    if (tid < NE) { const int c = lcnt[tid]; lbase[tid] = c ? (int)__hip_atomic_fetch_add((unsigned*)(ws + WS_CTL) + CW_CNT + l * NE + tid, (unsigned)c, __ATOMIC_RELAXED, __HIP_MEMORY_SCOPE_AGENT) : 0; }
    __syncthreads();
    if (tid < 128) { const LAS int* en = ent + tid * 3; ((unsigned*)(ws + WS_LIST))[(size_t)en[0] * T + lbase[en[0]] + en[2]] = (unsigned)en[1]; }
    }
    __syncthreads();
}

__device__ __forceinline__ void conv_tile(Frame& F, int l, int tile) {
    unsigned char* ws = KP->ws;
    PHASE_IDS;
    const int c0 = 2 * tid;
    const int row0 = tile * 32, t0 = row0 & (SEQ - 1);
    LAS float* C = (LAS float*)F.lds;
    {
        f32x2v w2[CW];
        const float* cw = KP->conv_w + (size_t)l * CW * CCH + c0;
#pragma unroll
        for (int k = 0; k < CW; ++k) w2[k] = *(const f32x2v*)(cw + k * CCH);
        const f32x2v cb = *(const f32x2v*)(KP->conv_b + l * CCH + c0);
        const bf16* Z = (const bf16*)(ws + WS_Z) + c0;
        unsigned zw[62];
#pragma unroll
        for (int i = 0; i < 62; ++i) { const int dt = i - (CW - 1); zw[i] = 0u; if (t0 + dt >= 0) zw[i] = __builtin_nontemporal_load((const unsigned*)(Z + (size_t)(row0 + dt) * CCH)); }
#pragma unroll
        for (int hh = 0; hh < 2; ++hh) {
            f32x2v z2[46];
#pragma unroll
            for (int i = 0; i < 46; ++i) z2[i] = (f32x2v){__uint_as_float(zw[hh * 16 + i] << 16), __uint_as_float(zw[hh * 16 + i] & 0xffff0000u)};
#pragma unroll
            for (int o = 0; o < 16; ++o) { f32x2v a = cb;
#pragma unroll
                for (int k = 0; k < CW; ++k) a = __builtin_elementwise_fma(w2[k], z2[o + k], a);
                *(LAS f32x2v*)(C + (hh * 16 + o) * CCH + c0) = a; }
        }
    }
    __syncthreads();
#pragma unroll
    for (int q = 0; q < 4; ++q) {
        const int tk = wave * 4 + q, row = row0 + tk;
        f32x4 v[4]; float s = 0.f;
#pragma unroll
        for (int j = 0; j < 4; ++j) { v[j] = *(const LAS f32x4*)(C + tk * CCH + 256 * j + 4 * lane); s += (v[j][0] + v[j][1]) + (v[j][2] + v[j][3]); }
        const float mu = wave_sum(s) * (1.f / CCH); float qq = 0.f;
#pragma unroll
        for (int j = 0; j < 4; ++j) { v[j] = v[j] - mu; qq += (v[j][0] * v[j][0] + v[j][1] * v[j][1]) + (v[j][2] * v[j][2] + v[j][3] * v[j][3]); }
        const float rstd = 1.f / sqrtf(wave_sum(qq) * (1.f / CCH) + EPS);
        float q2 = 0.f;
#pragma unroll
        for (int j = 0; j < 4; ++j) { const f32x4 g = *((const f32x4*)(KP->conv_ln_g + l * CCH) + 64 * j + lane), bb = *((const f32x4*)(KP->conv_ln_b + l * CCH) + 64 * j + lane);
#pragma unroll
            for (int i = 0; i < 4; ++i) { const float y = v[j][i] * rstd * g[i] + bb[i]; v[j][i] = siluf_(y); q2 += v[j][i] * v[j][i]; } }
        const float r2 = 1.f / sqrtf(wave_sum(q2) * (1.f / CCH) + EPS);
        v2u* ao = (v2u*)((bf16*)(ws + WS_AO) + (size_t)row * D + SCH) + lane;
#pragma unroll
        for (int j = 0; j < 4; ++j) { const f32x4 g = *((const f32x4*)(KP->onc_g + l * CCH) + 64 * j + lane); v2u o; o.x = pk2(v[j][0] * r2 * g[0], v[j][1] * r2 * g[1]); o.y = pk2(v[j][2] * r2 * g[2], v[j][3] * r2 * g[3]); ao[64 * j] = o; }
    }
    __syncthreads();
}


constexpr size_t SSMM_STRIDE = 256 * 1024, SSMM_WM = 192 * 1024;
__device__ __forceinline__ void p0_ssm_mats(Frame& F, int lg) {
    PHASE_IDS;
    const int l = lg / NG, g = lg % NG;
    LAS float* PWr = (LAS float*)F.lds;
    LAS float* PWi = PWr + 17 * 64;
    LAS float* BBr = PWi + 17 * 64;
    LAS float* BBi = BBr + 1024;
    LAS float* CCr = BBi + 1024;
    LAS float* CCi = CCr + 1024;
    LAS float* KT = CCi + 1024;
    LAS float* DS = KT + 4096;
    const float dt = expf(KP->log_dt[l * NG + g]);
    for (int i = tid; i < 17 * 64; i += NTHR) { const int k = i >> 6, p = i & 63; const float lr = KP->a_re[(l * NG + g) * NP + p], li = KP->a_im[(l * NG + g) * NP + p];
        const float mag = expf(lr * dt * (float)k), ang = li * dt * (float)k; PWr[i] = mag * cosf(ang); PWi[i] = mag * sinf(ang); }
    for (int i = tid; i < 1024; i += NTHR) { const int p = i >> 4, h = i & 15; const float lr = KP->a_re[(l * NG + g) * NP + p], li = KP->a_im[(l * NG + g) * NP + p];
        const float mag = expf(lr * dt), ang = li * dt, ar = mag * cosf(ang), ai = mag * sinf(ang), den = lr * lr + li * li, nr = ar - 1.f, ni = ai;
        const float fr = (nr * lr + ni * li) / den, fi = (ni * lr - nr * li) / den;
        const float br = KP->b_re[((size_t)(l * NG + g) * NP + p) * GW + h], bi = KP->b_im[((size_t)(l * NG + g) * NP + p) * GW + h];
        BBr[i] = fr * br - fi * bi; BBi[i] = fr * bi + fi * br;
        CCr[i] = KP->c_re[(size_t)(l * NG + g) * GW * NP + i]; CCi[i] = KP->c_im[(size_t)(l * NG + g) * GW * NP + i]; }
    if (tid < 16) DS[tid] = KP->ssm_d[l * SCH + g * GW + tid];
    if (tid < 64) { float* a16 = (float*)(KP->ws + WS_A16) + ((size_t)lg * NP + tid) * 2; const float lr = KP->a_re[(l * NG + g) * NP + tid], li = KP->a_im[(l * NG + g) * NP + tid];
        const float mag = expf(lr * dt * 16.f), ang = li * dt * 16.f; a16[0] = mag * cosf(ang); a16[1] = mag * sinf(ang); }
    __syncthreads();
    {
        const int k = tid >> 5, h = (tid >> 1) & 15, h0 = (tid & 1) * 8;
        float acc[8];
#pragma unroll
        for (int j = 0; j < 8; ++j) acc[j] = 0.f;
        for (int p = 0; p < 64; ++p) { const float cr = CCr[h * 64 + p], ci = CCi[h * 64 + p], pr = PWr[k * 64 + p], pi = PWi[k * 64 + p];
            const float zr = cr * pr - ci * pi, zi = cr * pi + ci * pr;
#pragma unroll
            for (int j = 0; j < 8; ++j) acc[j] += zr * BBr[p * 16 + h0 + j] - zi * BBi[p * 16 + h0 + j]; }
#pragma unroll
        for (int j = 0; j < 8; ++j) KT[(k * 16 + h) * 16 + h0 + j] = acc[j];
    }
    __syncthreads();
    v4u* tvf = (v4u*)(KP->ws + WS_SSMM + (size_t)lg * SSMM_STRIDE);
    v4u* wmf = (v4u*)(KP->ws + WS_SSMM + (size_t)lg * SSMM_STRIDE + SSMM_WM);
    const int fr = lane & 15, fq = lane >> 4;
    for (int f = wave; f < 192; f += NWAVES) {
        const int nt = f / 12, ks = f % 12, tau = nt, h = fr; float v[8];
        if (ks < 8) { const int sg = 2 * ks + (fq >> 1), h0 = 8 * (fq & 1), lag = tau - sg;
#pragma unroll
            for (int j = 0; j < 8; ++j) { float x = (lag >= 0) ? KT[(lag * 16 + h) * 16 + h0 + j] : 0.f; if (lag == 0 && h0 + j == h) x += DS[h]; v[j] = x; }
        } else { const int j0 = (ks - 8) * 32 + 8 * fq;
#pragma unroll
            for (int q = 0; q < 4; ++q) { const int p = (j0 >> 1) + q; const float cr = CCr[h * 64 + p], ci = CCi[h * 64 + p], pr = PWr[(tau + 1) * 64 + p], pi = PWi[(tau + 1) * 64 + p];
                v[2 * q] = cr * pr - ci * pi; v[2 * q + 1] = -(cr * pi + ci * pr); }
        }
        tvf[(size_t)f * 64 + lane] = (v4u){pk2(v[0], v[1]), pk2(v[2], v[3]), pk2(v[4], v[5]), pk2(v[6], v[7])};
    }
    for (int f = wave; f < 64; f += NWAVES) {
        const int nt = f >> 3, ks = f & 7, j = nt * 16 + fr, p = j >> 1, c = j & 1, sg = 2 * ks + (fq >> 1), h0 = 8 * (fq & 1); float v[8];
        const float pr = PWr[(15 - sg) * 64 + p], pi = PWi[(15 - sg) * 64 + p];
#pragma unroll
        for (int q = 0; q < 8; ++q) { const float br = BBr[p * 16 + h0 + q], bi = BBi[p * 16 + h0 + q]; v[q] = c ? (pr * bi + pi * br) : (pr * br - pi * bi); }
        wmf[(size_t)f * 64 + lane] = (v4u){pk2(v[0], v[1]), pk2(v[2], v[3]), pk2(v[4], v[5]), pk2(v[6], v[7])};
    }
    __syncthreads();
}

constexpr int SSM_RS = 528;
__device__ __forceinline__ void ssm_unit(Frame& F, int l, int b, int g) {
    PHASE_IDS;
    unsigned char* ws = KP->ws;
    const int fr = lane & 15, fq = lane >> 4, lg = l * NG + g;
    const int ntl = wave, nth = 15 - wave, kl = ntl >> 1, kh = nth >> 1;
    LAS unsigned char* Al = F.lds;
    LAS unsigned char* El = F.lds + 128 * SSM_RS;
    const v4u* tvf = (const v4u*)(ws + WS_SSMM + (size_t)lg * SSMM_STRIDE) + lane;
    const v4u* wmf = (const v4u*)(ws + WS_SSMM + (size_t)lg * SSMM_STRIDE + SSMM_WM) + lane;
    v4u w1[8], tl[4], th[8], sl[4], sh[4];
#pragma unroll
    for (int ks = 0; ks < 8; ++ks) w1[ks] = wmf[(size_t)(wave * 8 + ks) * 64];
#pragma unroll
    for (int ks = 0; ks < 4; ++ks) { tl[ks] = (v4u){0u, 0u, 0u, 0u}; if (ks <= kl) tl[ks] = tvf[(size_t)(ntl * 12 + ks) * 64]; }
#pragma unroll
    for (int ks = 0; ks < 8; ++ks) { th[ks] = (v4u){0u, 0u, 0u, 0u}; if (ks <= kh) th[ks] = tvf[(size_t)(nth * 12 + ks) * 64]; }
#pragma unroll
    for (int ks = 0; ks < 4; ++ks) { sl[ks] = tvf[(size_t)(ntl * 12 + 8 + ks) * 64]; sh[ks] = tvf[(size_t)(nth * 12 + 8 + ks) * 64]; }
    {
        const v4u* src = (const v4u*)((const bf16*)(ws + WS_U) + ((size_t)b * NG + g) * SEQ * GW);
        v4u av[8];
#pragma unroll
        for (int it = 0; it < 8; ++it) av[it] = src[it * NTHR + tid];
#pragma unroll
        for (int it = 0; it < 8; ++it) { const int idx = it * NTHR + tid; *(LAS v4u*)(Al + (idx >> 5) * SSM_RS + (idx & 31) * 16) = av[it]; }
    }
    __syncthreads();
#define SSM_AFR(dst, base, koff) do { _Pragma("unroll") for (int m = 0; m < 8; ++m) dst[m] = *(const LAS bf16x8*)((base) + (m * 16 + fr) * SSM_RS + (koff)); } while (0)
    {
        f32x4 acc[8];
#pragma unroll
        for (int m = 0; m < 8; ++m) acc[m] = (f32x4){0.f, 0.f, 0.f, 0.f};
#pragma unroll
        for (int ks = 0; ks < 8; ++ks) { bf16x8 afr[8]; SSM_AFR(afr, Al, (ks * 32 + 8 * fq) * 2); const bf16x8 bfr = __builtin_bit_cast(bf16x8, w1[ks]);
#pragma unroll
            for (int m = 0; m < 8; ++m) acc[m] = __builtin_amdgcn_mfma_f32_16x16x32_bf16(bfr, afr[m], acc[m], 0, 0, 0); }
#pragma unroll
        for (int m = 0; m < 8; ++m) *(LAS f32x4*)(El + (m * 16 + fr) * SSM_RS + (wave * 16 + 4 * fq) * 4) = acc[m];
    }
    __syncthreads();
    {
        const f32x2v a16 = *(const f32x2v*)((const float*)(ws + WS_A16) + ((size_t)lg * NP + lane) * 2);
        LAS f32x2v* SE = (LAS f32x2v*)(F.lds + 2 * 128 * SSM_RS);
        f32x2v e[16];
#pragma unroll
        for (int c = 0; c < 16; ++c) e[c] = *(const LAS f32x2v*)(El + (wave * 16 + c) * SSM_RS + lane * 8);
        float lr[16], li[16]; float sr = 0.f, si = 0.f;
#pragma unroll
        for (int c = 0; c < 16; ++c) { lr[c] = sr; li[c] = si; const float nr = a16.x * sr - a16.y * si + e[c].x, ni = a16.x * si + a16.y * sr + e[c].y; sr = nr; si = ni; }
        SE[wave * 64 + lane] = (f32x2v){sr, si};
        float pr = a16.x, pi = a16.y;
#pragma unroll
        for (int q = 0; q < 4; ++q) { const float tr = pr * pr - pi * pi, ti = 2.f * pr * pi; pr = tr; pi = ti; }
        __syncthreads();
        float cr = 0.f, ci = 0.f;
        for (int v = 0; v < wave; ++v) { const f32x2v s = SE[v * 64 + lane]; const float nr = pr * cr - pi * ci + s.x, ni = pr * ci + pi * cr + s.y; cr = nr; ci = ni; }
#pragma unroll
        for (int c = 0; c < 16; ++c) { *(LAS unsigned*)(El + (wave * 16 + c) * SSM_RS + lane * 4) = pk2(lr[c] + cr, li[c] + ci);
            const float nr = a16.x * cr - a16.y * ci, ni = a16.x * ci + a16.y * cr; cr = nr; ci = ni; }
    }
    const bf16* SGp = (const bf16*)(ws + WS_SG) + ((size_t)b * NG + g) * SEQ * GW;
    v2u sgw[8][2];
#pragma unroll
    for (int m = 0; m < 8; ++m) { sgw[m][0] = *(const v2u*)(SGp + (size_t)((m * 16 + fr) * 16 + ntl) * GW + 4 * fq); sgw[m][1] = *(const v2u*)(SGp + (size_t)((m * 16 + fr) * 16 + nth) * GW + 4 * fq); }
    __syncthreads();
    {
        f32x4 acc[8][2];
#pragma unroll
        for (int m = 0; m < 8; ++m) { acc[m][0] = (f32x4){0.f, 0.f, 0.f, 0.f}; acc[m][1] = (f32x4){0.f, 0.f, 0.f, 0.f}; }
#pragma unroll
        for (int ks = 0; ks < 8; ++ks) {
            if (ks <= kh) { bf16x8 afr[8]; SSM_AFR(afr, Al, (ks * 32 + 8 * fq) * 2);
                const bf16x8 bh = __builtin_bit_cast(bf16x8, th[ks]);
#pragma unroll
                for (int m = 0; m < 8; ++m) acc[m][1] = __builtin_amdgcn_mfma_f32_16x16x32_bf16(bh, afr[m], acc[m][1], 0, 0, 0);
                if (ks < 4) { if (ks <= kl) { const bf16x8 bl = __builtin_bit_cast(bf16x8, tl[ks < 4 ? ks : 0]);
#pragma unroll
                    for (int m = 0; m < 8; ++m) acc[m][0] = __builtin_amdgcn_mfma_f32_16x16x32_bf16(bl, afr[m], acc[m][0], 0, 0, 0); } }
            }
        }
#pragma unroll
        for (int ks = 0; ks < 4; ++ks) { bf16x8 afr[8]; SSM_AFR(afr, El, (ks * 32 + 8 * fq) * 2);
            const bf16x8 bl = __builtin_bit_cast(bf16x8, sl[ks]), bh = __builtin_bit_cast(bf16x8, sh[ks]);
#pragma unroll
            for (int m = 0; m < 8; ++m) { acc[m][0] = __builtin_amdgcn_mfma_f32_16x16x32_bf16(bl, afr[m], acc[m][0], 0, 0, 0); acc[m][1] = __builtin_amdgcn_mfma_f32_16x16x32_bf16(bh, afr[m], acc[m][1], 0, 0, 0); } }
        bf16* AO = (bf16*)(ws + WS_AO); float* SSQ = (float*)(ws + WS_SSQ);
        const f32x4 gs = *(const f32x4*)(KP->ons_g + l * SCH + g * GW + 4 * fq);
#pragma unroll
        for (int m = 0; m < 8; ++m)
#pragma unroll
            for (int n = 0; n < 2; ++n) {
                const int tok = (m * 16 + fr) * 16 + (n ? nth : ntl);
                const v2u sw = sgw[m][n];
                const float s0 = __uint_as_float(sw.x << 16), s1 = __uint_as_float(sw.x & 0xffff0000u), s2 = __uint_as_float(sw.y << 16), s3 = __uint_as_float(sw.y & 0xffff0000u);
                const float v0 = gelu_tanh(acc[m][n][0]) * s0, v1 = gelu_tanh(acc[m][n][1]) * s1, v2 = gelu_tanh(acc[m][n][2]) * s2, v3 = gelu_tanh(acc[m][n][3]) * s3;
                float sq = (v0 * v0 + v1 * v1) + (v2 * v2 + v3 * v3);
                sq += shfl_xor_fresh(sq, 16); sq += shfl_xor_fresh(sq, 32);
                const size_t row = (size_t)b * SEQ + tok;
                v2u o; o.x = pk2(v0 * gs[0], v1 * gs[1]); o.y = pk2(v2 * gs[2], v3 * gs[3]);
                *(v2u*)(AO + row * D + g * GW + 4 * fq) = o;
                if (fq == 0) SSQ[row * NG + ((g >> 2) & 7) * 8 + (g >> 5) * 4 + (g & 3)] = sq;
            }
    }
#undef SSM_AFR
    __syncthreads();
}

__device__ __forceinline__ void moe_tables(Frame& F, int l) {
    LAS int* pt = (LAS int*)(F.lds + L_PTILE); LAS int* lc = (LAS int*)(F.lds + L_CNT);
    const int tq = fresh_tid(F.wv);
    if (tq < NE) lc[tq] = (int)__hip_atomic_load((const unsigned*)(KP->ws + WS_CTL) + CW_CNT + l * NE + tq, __ATOMIC_RELAXED, __HIP_MEMORY_SCOPE_AGENT);
    __syncthreads();
    if (tq == 0) { int acc = 0; for (int e = 0; e < NE; ++e) { pt[e] = acc; acc += (lc[e] + 255) >> 8; } pt[NE] = acc; }
    __syncthreads();
}

struct MArgs { Ptrs p; int ph_lo, ph_hi, use_bar, mix_mask; };
__global__ void __launch_bounds__(NTHR, 2) mega(MArgs args) {
    extern __shared__ __attribute__((aligned(16))) unsigned char lds_raw[];
    Frame F;
    F.lds = (LAS unsigned char*)lds_raw;
    F.wv = __builtin_amdgcn_readfirstlane((int)threadIdx.x >> 6);
    F.G = gridDim.x; { const int bx = blockIdx.x; F.vcu = (F.G % 8 == 0) ? (bx % 8) * (F.G / 8) + bx / 8 : bx; }
    for (int u = fresh_tid(F.wv); u < (LDS_BYTES - LCTL_OFF) / 4; u += NTHR) ((LAS unsigned*)(F.lds + LCTL_OFF))[u] = 0u;
    __syncthreads();
    XcdBarrier bar; bar.bar = (unsigned*)(KP->ws + WS_CTL) + CW_BAR; bar.x = 0; bar.st = nullptr; bar.wv = F.wv;
    if (args.use_bar) bar = xcd_barrier_post((unsigned*)(KP->ws + WS_CTL) + CW_BAR, (volatile LAS unsigned*)(F.lds + L_MISC) + 8, F.wv);
    const int lo = args.ph_lo, hi = args.ph_hi;
#ifndef PROBE_DUP
#define PROBE_DUP -1
#endif
#define DUPN(k) ((PROBE_DUP == (k)) ? PROBE_REPS : 1)
#define IN(k) (lo <= (k) && (k) < hi)
#define SEAM(k) do { if (IN(k) && IN((k) + 1)) xcd_barrier(bar); } while (0)
    for (int rep = 0; rep < DUPN(7); ++rep) { if (rep) xcd_barrier(bar);
    if (IN(0)) { p0_prologue(F); } }
    SEAM(0);
    for (int l = 0; l < NL; ++l) {
        const int pb = 1 + 7 * l;
#define WSP (KP->ws)
        for (int rep = 0; rep < DUPN(0); ++rep) { if (rep) xcd_barrier(bar);
        if (IN(pb + 0)) { if (l == 0) pn_rows<0, false>(F, l, KP->x, 0); else pn_rows<0, true>(F, l, nullptr, l - 1); } }
        SEAM(pb + 0);
        for (int rep = 0; rep < DUPN(1); ++rep) { if (rep) xcd_barrier(bar);
        if (IN(pb + 1)) {
            unsigned char* ws = WSP;
            pg8::Gemm g{(const bf16*)(ws + WS_H), (const bf16*)(ws + WS_WIN) + (size_t)l * INC * D, T, INC, D};
            const int gg = (l == 0 && F.G > G1_SPLIT) ? G1_SPLIT : F.G;
            if ((int)blockIdx.x < gg) {
                pg8::StaticOrder S; S.init(T, INC, gg, (int)blockIdx.x);
                EpiIn E{(bf16*)(ws + WS_Z), (bf16*)(ws + WS_U), (bf16*)(ws + WS_SG)};
                pg8::gemm_phase<EpiIn, pg8::StaticOrder, false, D>(F.lds, g, S, E, nullptr, F.wv);
            }
            if (l == 0) p0_queue(F);
        } }
        SEAM(pb + 1);
        for (int rep = 0; rep < DUPN(2); ++rep) { if (rep) xcd_barrier(bar);
        if (IN(pb + 2)) {
            if (args.mix_mask & 2) for (int u = (int)blockIdx.x; u < ((PROBE_DUP == 21) ? PROBE_REPS : 1) * NB * NG; u += F.G) {
                const int g_ = ((u & 7) << 2) + ((u & 8) << 2) + ((u >> 4) & 3), b_ = ((u >> 6) & 3) + (((u >> 8) & 1) << 2);
                ssm_unit(F, l, b_, g_); }
            if (args.mix_mask & 1) for (int tl = F.vcu; tl < ((PROBE_DUP == 20) ? PROBE_REPS : 1) * (T / 32); tl += F.G) conv_tile(F, l, tl % (T / 32));
        } }
        SEAM(pb + 2);
        for (int rep = 0; rep < DUPN(3); ++rep) { if (rep) xcd_barrier(bar);
        if (IN(pb + 3)) {
            unsigned char* ws = WSP;
            pg8::StaticOrder S; S.init(T, D, F.G, (int)blockIdx.x);
            LAS float* rs = (LAS float*)(F.lds + L_TAB);
            {
                pg8::Unit u0, u1; const bool ok0 = S.next(0, u0), ok1 = S.next(1, u1);
                const int tq = fresh_tid(F.wv), slot = tq >> 8, r = tq & 255; pg8::Unit u; u.pm = slot ? u1.pm : u0.pm;
                if (slot ? ok1 : ok0) { const f32x4* sq = (const f32x4*)((const float*)(ws + WS_SSQ) + (size_t)(u.pm * 256 + r) * NG); float s = 0.f;
#pragma unroll
                    for (int q = 0; q < 16; ++q) { const f32x4 v = sq[q]; s += (v[0] + v[1]) + (v[2] + v[3]); }
                    rs[slot * 256 + r] = 1.f / sqrtf(s * (1.f / SCH) + EPS); }
            }
            __syncthreads();
            pg8::Gemm g{(const bf16*)(ws + WS_AO), (const bf16*)(ws + WS_WOUT) + (size_t)l * D * D, T, D, D};
            EpiOut E{(bf16*)(ws + WS_XB), (const float*)(ws + WS_MOD) + (size_t)l * NB * 6 * D + 2 * D, rs};
            pg8::gemm_phase<EpiOut, pg8::StaticOrder, false, D>(F.lds, g, S, E, nullptr, F.wv);
        } }
        SEAM(pb + 3);
        for (int rep = 0; rep < DUPN(4); ++rep) { if (rep) xcd_barrier(bar);
        if (IN(pb + 4)) pn2_phase(F, l, rep == DUPN(4) - 1); }
        SEAM(pb + 4);
        for (int rep = 0; rep < DUPN(5); ++rep) { if (rep) xcd_barrier(bar);
        if (IN(pb + 5)) {
            unsigned char* ws = WSP;
            moe_tables(F, l);
            const LAS int* pt = (const LAS int*)(F.lds + L_PTILE); const LAS int* lc = (const LAS int*)(F.lds + L_CNT);
            pg8::MoeOrder S{pt, 4, F.G, F.vcu, __builtin_amdgcn_readfirstlane(pt[NE]) * 4, (PROBE_DUP == 15) ? 2 : 1};
            LAS int* tab = (LAS int*)(F.lds + L_TAB);
            {
                LAS int* sinfo = (LAS int*)(F.lds + L_CNT + 128);
#pragma unroll 1
                for (int s = 0; s < 4; ++s) { pg8::Unit u; const bool ok = S.next(s, u); if (fresh_tid(F.wv) == 0) { sinfo[2 * s] = ok ? u.e : -1; sinfo[2 * s + 1] = ok ? u.mloc : 0; } }
                __syncthreads();
                const int tq = fresh_tid(F.wv); unsigned ev[2];
#pragma unroll
                for (int j = 0; j < 2; ++j) { const int sl = (tq >> 8) + 2 * j, e = sinfo[2 * sl], idx = sinfo[2 * sl + 1] * 256 + (tq & 255); ev[j] = 0u;
                    if (e >= 0 && idx < lc[e]) ev[j] = ((const unsigned*)(ws + WS_LIST))[(size_t)e * T + idx]; }
#pragma unroll
                for (int j = 0; j < 2; ++j) tab[((tq >> 8) + 2 * j) * 256 + (tq & 255)] = (int)(ev[j] >> 1);
            }
            __syncthreads();
            pg8::Gemm g{(const bf16*)(ws + WS_H), (const bf16*)(ws + WS_GU) + (size_t)l * NE * 2 * FF * D, 0, 0, D};
            EpiMoe1 E{(bf16*)(ws + WS_HM), CW_HMC + l * 160 * 64};
            pg8::gemm_phase<EpiMoe1, pg8::MoeOrder, true, D>(F.lds, g, S, E, tab, F.wv);
        } }
#if defined(MOE_BARRIER)
        SEAM(pb + 5);
#endif
        for (int rep = 0; rep < DUPN(6); ++rep) { if (rep) xcd_barrier(bar);
        if (IN(pb + 6)) {
            unsigned char* ws = WSP;
            moe_tables(F, l);
            const LAS int* pt = (const LAS int*)(F.lds + L_PTILE); const LAS int* lc = (const LAS int*)(F.lds + L_CNT);
            const int tm_ = __builtin_amdgcn_readfirstlane(pt[NE]), r1_ = (tm_ * 4) % F.G;
#pragma unroll 1
            for (int part = 0; part < 2; ++part) {
                pg8::MoeOrder2 S{pt, 8, F.G, F.vcu, tm_ * 8, r1_, r1_ ? MOE2_PRE : 0, part};
                LAS unsigned* tent = (LAS unsigned*)(F.lds + L_TAB); LAS float* twt = (LAS float*)(F.lds + L_TAB + 7168);
                {
                    LAS int* sinfo = (LAS int*)(F.lds + L_CNT + 128);
                    unsigned* ctl = (unsigned*)(ws + WS_CTL);
                    bool any = false;
#pragma unroll 1
                    for (int s2 = 0; s2 < 8; ++s2) { pg8::Unit u; const bool ok = S.next(s2, u) && s2 < 7; any = any || ok;
                        if (fresh_tid(F.wv) == 0) { sinfo[2 * s2] = ok ? u.e : -1; sinfo[2 * s2 + 1] = ok ? u.mloc : 0; }
                        if (ok && fresh_wave(F.wv) == 0) { unsigned* w = ctl + CW_HMC + (l * 160 + u.pm) * 64; unsigned polls = 0;
                            while ((unsigned)__builtin_amdgcn_readfirstlane(__hip_atomic_load(w, __ATOMIC_RELAXED, __HIP_MEMORY_SCOPE_AGENT)) < 32u) {
                                if (++polls > (1u << 20)) { __hip_atomic_store(ctl + CW_TMO, 1u, __ATOMIC_RELAXED, __HIP_MEMORY_SCOPE_AGENT); break; }
                                __builtin_amdgcn_s_sleep(2); } } }
                    if (any && fresh_wave(F.wv) == 0) { __builtin_amdgcn_fence(__ATOMIC_ACQUIRE, "agent"); asm volatile("s_waitcnt vmcnt(0)" ::: "memory"); }
                    __syncthreads();
                    const int tq = fresh_tid(F.wv); unsigned ev[4]; float wv[4];
#pragma unroll
                    for (int j = 0; j < 4; ++j) { const int sl = (tq >> 8) + 2 * j, e = sinfo[2 * sl], idx = sinfo[2 * sl + 1] * 256 + (tq & 255); ev[j] = ~0u;
                        if (e >= 0 && idx < lc[e]) ev[j] = ((const unsigned*)(ws + WS_LIST))[(size_t)e * T + idx]; }
#pragma unroll
                    for (int j = 0; j < 4; ++j) wv[j] = (ev[j] != ~0u) ? ((const float*)(ws + WS_TOKW))[ev[j]] : 0.f;
#pragma unroll
                    for (int j = 0; j < 4; ++j) { const int sl = (tq >> 8) + 2 * j; if (sl < 7) { tent[sl * 256 + (tq & 255)] = ev[j]; twt[sl * 256 + (tq & 255)] = wv[j]; } }
                }
                __syncthreads();
                pg8::Gemm g{(const bf16*)(ws + WS_HM), (const bf16*)(ws + WS_DN) + (size_t)l * NE * D * FF, 0, 0, FF};
                EpiMoe2 E{(bf16*)(ws + WS_Y), tent, twt};
                pg8::gemm_phase<EpiMoe2, pg8::MoeOrder2, false, FF>(F.lds, g, S, E, nullptr, F.wv);
            }
        } }
        SEAM(pb + 6);
    }
    for (int rep = 0; rep < DUPN(8); ++rep) { if (rep) xcd_barrier(bar);
    if (IN(15)) pn_rows<2, true>(F, 0, nullptr, NL - 1); }
#undef WSP
#undef IN
#undef SEAM
}

extern "C" void kernel_launch(void* const* d_in, const int* in_sizes, int n_in, void* d_out, int out_size, void* d_ws, size_t ws_size, hipStream_t stream) {
    static int grid = 0;
    if (grid == 0) {
        if (n_in != 30 || ws_size < WS_END || out_size != T * D) { fprintf(stderr, "kernel_launch: unexpected n_in %d / out_size %d / ws_size %zu (need %zu)\n", n_in, out_size, ws_size, (size_t)WS_END); grid = -1; return; }
        int dev = 0, cus = 0, per_cu = 0;
        if (hipGetDevice(&dev) != hipSuccess || hipDeviceGetAttribute(&cus, hipDeviceAttributeMultiprocessorCount, dev) != hipSuccess) { grid = -1; return; }
        if (hipFuncSetAttribute((const void*)mega, hipFuncAttributeMaxDynamicSharedMemorySize, LDS_BYTES) != hipSuccess) { fprintf(stderr, "kernel_launch: hipFuncSetAttribute failed\n"); grid = -1; return; }
        if (hipOccupancyMaxActiveBlocksPerMultiprocessor(&per_cu, (const void*)mega, NTHR, LDS_BYTES) != hipSuccess || per_cu < 1) { fprintf(stderr, "kernel_launch: occupancy query reports %d workgroups per CU; nothing launched\n", per_cu); (void)hipGetLastError(); grid = -1; return; }
        if (cus != 256) { fprintf(stderr, "kernel_launch: built for 256 CUs, device has %d; nothing launched\n", cus); grid = -1; return; }
        grid = cus;
    }
    if (grid < 0) return;
    MArgs a{};
    const float** pp = (const float**)&a.p;
    for (int i = 0; i < 30; ++i) pp[i] = (const float*)d_in[i];
    a.p.out = (float*)d_out; a.p.ws = (unsigned char*)d_ws;
    a.ph_lo = 0; a.ph_hi = 16; a.use_bar = 1; a.mix_mask = 3;
    if (hipMemsetAsync((char*)d_ws + WS_CTL, 0, CTL_BYTES, stream) != hipSuccess) { fprintf(stderr, "kernel_launch: memset failed\n"); return; }
    hipLaunchKernelGGL(mega, dim3(grid), dim3(NTHR), LDS_BYTES, stream, a);
    const hipError_t le = hipPeekAtLastError();
    if (le != hipSuccess) fprintf(stderr, "kernel_launch: launch failed: %s\n", hipGetErrorName(le));
}
```

```cpp
#include <hip/hip_runtime.h>
#include <cstdio>
#include <cstdint>

constexpr int NB = 8, SEQ = 2048, D = 2048, T = NB * SEQ, NL = 2;
constexpr int CCH = 1024, SCH = 1024, CW = 31, NG = 64, GW = 16, NP = 64, INC = 4096;
constexpr int NE = 32, EPG = 8, NGR = 4, FF = 512;
constexpr float EPS = 1e-6f;

typedef unsigned short bf16;
typedef float f32x4 __attribute__((ext_vector_type(4)));
__device__ __forceinline__ float bf2f(bf16 v) { return __uint_as_float(((unsigned)v) << 16); }
__device__ __forceinline__ bf16 f2bf(float f) { unsigned u = __float_as_uint(f); return (bf16)((u + 0x7fffu + ((u >> 16) & 1u)) >> 16); }
__device__ __forceinline__ float sigmoidf_(float x) { return __builtin_amdgcn_rcpf(1.f + __expf(-x)); }
__device__ __forceinline__ float siluf_(float x) { return x * sigmoidf_(x); }
__device__ __forceinline__ float gelu_tanh(float y) { const float u = 1.5957691216057308f * (y + 0.044715f * y * y * y); return y * sigmoidf_(u); }

constexpr size_t MiB = 1u << 20;
constexpr size_t WS_CTL = 0, CTL_BYTES = 1 * MiB;
constexpr size_t WS_MOD = 1 * MiB;
constexpr size_t WS_SSMM = 2 * MiB;
constexpr size_t WS_A16 = 34 * MiB;
constexpr size_t WS_TOKE = 35 * MiB;
constexpr size_t WS_TOKW = 35 * MiB + 512 * 1024;
constexpr size_t WS_LIST = 36 * MiB;
constexpr size_t WS_SSQ = 38 * MiB;
constexpr size_t WS_RW = 42 * MiB;
constexpr size_t WS_WIN = 48 * MiB, WS_WOUT = 80 * MiB, WS_GU = 96 * MiB, WS_DN = 352 * MiB;
constexpr size_t WS_XA = 480 * MiB, WS_XB = 608 * MiB, WS_H = 736 * MiB;
constexpr size_t WS_Z = 800 * MiB, WS_U = 832 * MiB, WS_SG = 864 * MiB, WS_AO = 896 * MiB, WS_HM = 960 * MiB;
constexpr size_t WS_Y = 800 * MiB;
constexpr size_t WS_TMP = 1000 * MiB;
constexpr size_t WS_END = 1064 * MiB;
constexpr int CW_CNT = 1024;
constexpr int HM_ROWS = 2 * T + NE * 256;

struct Ptrs {
    const float *x, *c, *w_ada, *b_ada, *norm1_g, *w_in, *conv_w, *conv_b, *conv_ln_g, *conv_ln_b;
    const float *a_re, *a_im, *b_re, *b_im, *c_re, *c_im, *ssm_d, *log_dt, *onc_g, *ons_g, *w_out, *norm2_g;
    const float *rg_w, *rg_b, *re_w, *re_b, *w_gate, *w_up, *w_down, *final_g;
    float* out; unsigned char* ws;
};

#ifndef PROBE_REPS
#define PROBE_REPS 2
#endif
#ifndef PROBE_DUP
#define PROBE_DUP -1
#endif
__device__ __forceinline__ unsigned* ctl_words();
namespace pg8 {
#define PG8_LAS __attribute__((address_space(3)))
typedef unsigned short bf16_t;
typedef short bf16x8 __attribute__((ext_vector_type(8)));
typedef float f32x4 __attribute__((ext_vector_type(4)));
typedef unsigned u32x4 __attribute__((ext_vector_type(4)));
constexpr int BM = 256, BK = 64, HALF = 128, HTB = HALF * BK * 2, STAGE_BYTES = 8 * HTB, NXCD = 8, WGM = 4;

__host__ __device__ __forceinline__ int lds_byte(int r, int c) { const int st = (r >> 4) * 2 + (c >> 5), rr = r & 15, cc = c & 31, ob = rr * 64 + cc * 2; return st * 1024 + (ob ^ (((ob >> 9) & 1) << 5)); }
__host__ __device__ __forceinline__ void stage_rc(int b, int& R, int& C) { const int st = b / 1024, sb = b % 1024, swz = sb ^ (((sb >> 9) & 1) << 5); R = (st >> 1) * 16 + swz / 64; C = (st & 1) * 32 + (swz % 64) / 2; }
__host__ __device__ __forceinline__ int perm32(int rho) { const int n = rho >> 4, i = rho & 15; return 8 * (i >> 2) + 4 * n + (i & 3); }

struct Unit { int pm, pn, e, mloc; };
struct Gemm { const bf16_t* A; const bf16_t* Bt; int M, N, K; };

struct StaticOrder {
    int nM, nN, nwg, G, c;
    __device__ void init(int M, int N, int G_, int c_) { nM = M / BM; nN = N / BM; nwg = nM * nN; G = G_; c = c_; }
    __device__ bool next(int i, Unit& u) const {
        const long L = (long)i * G + c; if (L >= nwg) return false;
        int wgid = (int)L; { const int q = nwg / NXCD, r = nwg % NXCD, xcd = wgid % NXCD, off = wgid / NXCD; wgid = (xcd < r ? xcd * (q + 1) : r * (q + 1) + (xcd - r) * q) + off; }
        const int nig = WGM * nN, gid = wgid / nig, fm = gid * WGM, gsz = (nM - fm) < WGM ? (nM - fm) : WGM;
        u.pm = fm + ((wgid % nig) % gsz); u.pn = (wgid % nig) / gsz; u.e = 0; u.mloc = 0; return true;
    }
};
struct MoeOrder {
    const PG8_LAS int* ptile; int npn, G, c, total, rep;
    __device__ __forceinline__ void decode(int j, Unit& u) const {
        const int mt = j / npn, pn = j % npn;
        int ln_ = (int)__builtin_amdgcn_mbcnt_hi(~0u, __builtin_amdgcn_mbcnt_lo(~0u, 0u)); asm volatile("" : "+v"(ln_));
        const int pv = ptile[(ln_ & 31) + 1];
        const int e = __builtin_popcountll(__ballot(pv <= mt) & 0xffffffffull);
        u.pm = mt; u.pn = e * npn + pn; u.e = e; u.mloc = __builtin_amdgcn_readfirstlane(mt - ptile[e]);
    }
    __device__ bool next(int i, Unit& u) const {
        long L = (long)i * G + c; if (L >= (long)total * rep) return false;
        if (L >= total) L -= total;
        decode((int)L, u); return true;
    }
};
struct MoeOrder2 {
    const PG8_LAS int* ptile; int npn, G, c, total, r, pre, part;
    __device__ bool next(int i, Unit& u) const {
        const int preN = pre * (G - r); int j;
        if (part == 0) { if (c < r || i >= pre) return false; j = i * (G - r) + (c - r); }
        else j = preN + i * G + c;
        if (j >= total) return false;
        MoeOrder o{ptile, npn, G, c, total, 1}; o.decode(j, u); return true;
    }
};

__device__ __forceinline__ unsigned cvt_pk_bf16(float lo, float hi) { unsigned r; asm volatile("v_cvt_pk_bf16_f32 %0, %1, %2" : "=v"(r) : "v"(lo), "v"(hi)); return r; }

template <class Epi, class Sched, bool GATHER, int KC>
__device__ __forceinline__ void gemm_phase(PG8_LAS unsigned char* lds, const Gemm g, const Sched& S, const Epi& E, const PG8_LAS int* rowtab, const int wv) {
    int tid_ = wv * 64 + (int)__builtin_amdgcn_mbcnt_hi(~0u, __builtin_amdgcn_mbcnt_lo(~0u, 0u)); asm volatile("" : "+v"(tid_));
    const int tid = tid_, wid = wv, lane = tid & 63, wr = wid >> 2, wc = wid & 3, fr = lane & 15, fq = lane >> 4;
    constexpr int K = KC, nt = K / BK;
    unsigned voffA[2], voffB[2]; int Rr[2];
#pragma unroll
    for (int i = 0; i < 2; ++i) { int R, C; stage_rc(tid * 16 + i * 8192, R, C); const int Rb = Epi::PERM ? ((R & ~31) + perm32(R & 31)) : R;
        voffA[i] = GATHER ? (unsigned)(C * 2) : (unsigned)(R * K + C) * 2u; voffB[i] = (unsigned)(Rb * K + C) * 2u; Rr[i] = R; }
    constexpr size_t kstep = (size_t)(BK * 2);
    constexpr size_t hstep = (size_t)HALF * K * 2;
    constexpr size_t tstep = 2 * hstep;
    const unsigned ldsw = (unsigned)wid * 1024u;
    const int aoff = lds_byte(wr * 64 + fr, fq * 8), boff = lds_byte(wc * 32 + fr, fq * 8);
#define PG8_SA(b, h) (((b) * 2 + (h)) * HTB)
#define PG8_SB(b, h) ((4 + (b) * 2 + (h)) * HTB)
#define PG8_STAGE(bufoff, gbase, voff) do { _Pragma("unroll") for (int _i = 0; _i < 2; ++_i) \
        __builtin_amdgcn_global_load_lds((const unsigned*)((const char*)(gbase) + (voff)[_i]), (PG8_LAS unsigned*)(lds + (bufoff) + ldsw + _i * 8192), 16, 0, 0); } while (0)
#define PG8_STA(bufoff, usel, h, kb) do { if constexpr (GATHER) { unsigned _o[2]; _o[0] = (usel) ? gan[h][0] : gac[h][0]; _o[1] = (usel) ? gan[h][1] : gac[h][1]; PG8_STAGE(bufoff, gA + (kb), _o); } \
        else { PG8_STAGE(bufoff, ((usel) ? nA : cA) + (h) * hstep + (kb), voffA); } } while (0)
#define PG8_LDA(dst, b, h) do { _Pragma("unroll") for (int m = 0; m < 4; ++m) _Pragma("unroll") for (int k = 0; k < 2; ++k) dst[m][k] = *(const PG8_LAS bf16x8*)(lds + PG8_SA(b, h) + aoff + m * 2048 + k * 1024); } while (0)
#define PG8_LDB(dst, b, h) do { _Pragma("unroll") for (int n = 0; n < 2; ++n) _Pragma("unroll") for (int k = 0; k < 2; ++k) dst[n][k] = *(const PG8_LAS bf16x8*)(lds + PG8_SB(b, h) + boff + n * 2048 + k * 1024); } while (0)
#define PG8_MMA(ai, bj, At, Bt) do { __builtin_amdgcn_s_setprio(1); _Pragma("unroll") for (int m = 0; m < 4; ++m) _Pragma("unroll") for (int n = 0; n < 2; ++n) _Pragma("unroll") for (int k = 0; k < 2; ++k) \
        acc[ai][bj][m][n] = __builtin_amdgcn_mfma_f32_16x16x32_bf16(Bt[n][k], At[m][k], acc[ai][bj][m][n], 0, 0, 0); __builtin_amdgcn_s_setprio(0); } while (0)
#define PG8_WAIT_V(n) asm volatile("s_waitcnt vmcnt(" #n ")" ::: "memory")
#define PG8_WAIT_L(n) asm volatile("s_waitcnt lgkmcnt(" #n ")" ::: "memory")
#define PG8_BAR __builtin_amdgcn_s_barrier()
#define PG8_SCHED __builtin_amdgcn_sched_barrier(0)
#define PG8_GROWS(dst, slot) do { _Pragma("unroll") for (int _h = 0; _h < 2; ++_h) _Pragma("unroll") for (int _i = 0; _i < 2; ++_i) \
        dst[_h][_i] = (unsigned)rowtab[(slot) * 256 + _h * 128 + Rr[_i]] * (unsigned)(K * 2) + voffA[_i]; } while (0)
    Unit cur, nxt; int ui = 0;
    if (!S.next(0, cur)) return;
    f32x4 acc[2][2][4][2];
#pragma unroll
    for (int a = 0; a < 2; ++a)
#pragma unroll
        for (int b = 0; b < 2; ++b)
#pragma unroll
            for (int m = 0; m < 4; ++m)
#pragma unroll
                for (int n = 0; n < 2; ++n) acc[a][b][m][n] = (f32x4){0.f, 0.f, 0.f, 0.f};
    bf16x8 At[4][2], B0[2][2], B1[2][2];
    const char* const gA = (const char*)g.A;
    const char* cA = gA + (size_t)cur.pm * tstep; const char* cB = (const char*)g.Bt + (size_t)cur.pn * tstep;
    const char* nA = cA;
    unsigned gac[2][2], gan[2][2];
    if constexpr (GATHER) { PG8_GROWS(gac, 0); } else { gac[0][0] = gac[0][1] = gac[1][0] = gac[1][1] = 0u; }
#pragma unroll
    for (int h = 0; h < 2; ++h) { gan[h][0] = gac[h][0]; gan[h][1] = gac[h][1]; }
    PG8_STAGE(PG8_SB(0, 0), cB, voffB); PG8_STAGE(PG8_SB(0, 1), cB + hstep, voffB); PG8_STA(PG8_SA(0, 0), 0, 0, (size_t)0); PG8_STA(PG8_SA(0, 1), 0, 1, (size_t)0);
    if (wr == 1) PG8_BAR;
    PG8_WAIT_V(2); PG8_BAR;
    PG8_STAGE(PG8_SB(1, 0), cB + kstep, voffB); PG8_STA(PG8_SA(1, 0), 0, 0, kstep); PG8_STAGE(PG8_SB(1, 1), cB + hstep + kstep, voffB);
    PG8_WAIT_V(6); PG8_BAR;
    for (;;) {
        const bool has_next = S.next(ui + 1, nxt);
        nA = has_next ? gA + (size_t)nxt.pm * tstep : cA; const char* nB = has_next ? (const char*)g.Bt + (size_t)nxt.pn * tstep : cB;
        if constexpr (GATHER) { if (has_next) { PG8_GROWS(gan, ui + 1); } }
        for (int t = 0; t < nt; t += 2) {
            const bool last = (t == nt - 2);
            const size_t kb1 = (size_t)(t + 1) * kstep;
            const size_t kb2 = last ? (size_t)0 : (size_t)(t + 2) * kstep;
            const char* b2 = last ? nB : cB + (size_t)(t + 2) * kstep;
            const char* b3 = b2 + kstep;
            if constexpr (Epi::MIDSCALE) { if (t == nt / 2) E.midscale(acc, ui, wr, fr); }
            PG8_LDB(B0, 0, 0); PG8_LDB(B1, 0, 1); PG8_SCHED; PG8_LDA(At, 0, 0); PG8_STA(PG8_SA(1, 1), 0, 1, kb1);
            PG8_WAIT_V(8); PG8_WAIT_L(0); PG8_BAR; PG8_MMA(0, 0, At, B0); PG8_MMA(0, 1, At, B1); PG8_BAR; PG8_SCHED;
            PG8_LDA(At, 0, 1); PG8_STAGE(PG8_SB(0, 0), b2, voffB); PG8_STAGE(PG8_SB(0, 1), b2 + hstep, voffB); PG8_STA(PG8_SA(0, 0), last, 0, kb2);
            PG8_WAIT_V(8); PG8_WAIT_L(0); PG8_BAR; PG8_MMA(1, 0, At, B0); PG8_MMA(1, 1, At, B1); PG8_BAR; PG8_SCHED;
            PG8_LDB(B0, 1, 0); PG8_LDB(B1, 1, 1); PG8_SCHED; PG8_LDA(At, 1, 0); PG8_STA(PG8_SA(0, 1), last, 1, kb2);
            PG8_WAIT_V(8); PG8_WAIT_L(0); PG8_BAR; PG8_MMA(0, 0, At, B0); PG8_MMA(0, 1, At, B1); PG8_BAR; PG8_SCHED;
            PG8_LDA(At, 1, 1); PG8_STAGE(PG8_SB(1, 0), b3, voffB); PG8_STAGE(PG8_SB(1, 1), b3 + hstep, voffB); PG8_STA(PG8_SA(1, 0), last, 0, kb2 + kstep);
            PG8_WAIT_V(8); PG8_WAIT_L(0); PG8_BAR; PG8_MMA(1, 0, At, B0); PG8_MMA(1, 1, At, B1); PG8_BAR; PG8_SCHED;
        }
        if (wr == 0) PG8_BAR;
        E(acc, cur, ui, wr, wc, fr, fq);
        if (!has_next) break;
#pragma unroll
        for (int a = 0; a < 2; ++a)
#pragma unroll
            for (int b = 0; b < 2; ++b)
#pragma unroll
                for (int m = 0; m < 4; ++m)
#pragma unroll
                    for (int n = 0; n < 2; ++n) acc[a][b][m][n] = (f32x4){0.f, 0.f, 0.f, 0.f};
        cur = nxt; cA = nA; cB = nB; ++ui;
#pragma unroll
        for (int h = 0; h < 2; ++h) { gac[h][0] = gan[h][0]; gac[h][1] = gan[h][1]; }
        if (wr == 1) PG8_BAR;
    }
    PG8_WAIT_V(0);
    PG8_BAR;
#undef PG8_SA
#undef PG8_SB
#undef PG8_STAGE
#undef PG8_STA
#undef PG8_LDA
#undef PG8_LDB
#undef PG8_MMA
#undef PG8_WAIT_V
#undef PG8_WAIT_L
#undef PG8_BAR
#undef PG8_SCHED
#undef PG8_GROWS
}
}

constexpr int NWAVES = 8, NTHR = NWAVES * 64;
constexpr int SCR_BYTES = 148480;
constexpr int LCTL_OFF = SCR_BYTES;
constexpr int L_MISC = LCTL_OFF;
constexpr int L_PTILE = LCTL_OFF + 128;
constexpr int L_CNT = LCTL_OFF + 320;
constexpr int L_TAB = LCTL_OFF + 512;
constexpr int LDS_BYTES = 163840;
static_assert(L_TAB + 14336 <= LDS_BYTES, "LDS map");

#define GAS __attribute__((address_space(1)))
#define LAS __attribute__((address_space(3)))
typedef float f32x2v __attribute__((ext_vector_type(2)));
typedef unsigned v4u __attribute__((ext_vector_type(4)));
typedef unsigned v2u __attribute__((ext_vector_type(2)));
typedef short bf16x8 __attribute__((ext_vector_type(8)));
typedef _Float16 f16x8 __attribute__((ext_vector_type(8)));
typedef _Float16 f16x2 __attribute__((ext_vector_type(2)));
#define LDS_WAIT() asm volatile("s_waitcnt lgkmcnt(0)" ::: "memory")
#define VM_WAIT() asm volatile("s_waitcnt vmcnt(0)" ::: "memory")
typedef __bf16 bf16x2_hw __attribute__((ext_vector_type(2)));
__device__ __forceinline__ unsigned pk2(float lo, float hi) { const f32x2v v = {lo, hi}; const bf16x2_hw b = __builtin_convertvector(v, bf16x2_hw); return __builtin_bit_cast(unsigned, b); }
__device__ __forceinline__ float dpp_add(float v, const int ctrl_sel) {
    int x = __builtin_bit_cast(int, v), y;
    if (ctrl_sel == 0) y = __builtin_amdgcn_update_dpp(0, x, 0xB1, 0xf, 0xf, true);
    else if (ctrl_sel == 1) y = __builtin_amdgcn_update_dpp(0, x, 0x4E, 0xf, 0xf, true);
    else if (ctrl_sel == 2) y = __builtin_amdgcn_update_dpp(0, x, 0x141, 0xf, 0xf, true);
    else y = __builtin_amdgcn_update_dpp(0, x, 0x140, 0xf, 0xf, true);
    return v + __builtin_bit_cast(float, y);
}
__device__ __forceinline__ float row16_sum(float v) { v = dpp_add(v, 0); v = dpp_add(v, 1); v = dpp_add(v, 2); v = dpp_add(v, 3); return v; }
__device__ __forceinline__ float wave_sum(float v) {
    v = row16_sum(v);
    const int x = __builtin_bit_cast(int, v);
    const float r0 = __builtin_bit_cast(float, __builtin_amdgcn_readlane(x, 0)), r1 = __builtin_bit_cast(float, __builtin_amdgcn_readlane(x, 16));
    const float r2 = __builtin_bit_cast(float, __builtin_amdgcn_readlane(x, 32)), r3 = __builtin_bit_cast(float, __builtin_amdgcn_readlane(x, 48));
    return (r0 + r1) + (r2 + r3);
}
__device__ __forceinline__ float shfl_xor_fresh(float v, int mask) {
    int l = __builtin_amdgcn_mbcnt_hi(~0u, __builtin_amdgcn_mbcnt_lo(~0u, 0u)); asm volatile("" : "+v"(l));
    return __builtin_bit_cast(float, __builtin_amdgcn_ds_bpermute((l ^ mask) << 2, __builtin_bit_cast(int, v)));
}

#define XB_TMO      128
#define XB_XCNT(j)  (256  + 64 * (j))
#define XB_XSUB(j)  (1280 + 64 * (j))
#define XB_XGEN(j)  (2304 + 64 * (j))
#define XB_TOP      3328
#define XB_TOPGEN   3392
#define XCD_BAR_WORDS 3456
#define XB_SPIN_CAP (1u << 18)
__device__ __forceinline__ unsigned xb_ld(unsigned* p)              { return __hip_atomic_load(p, __ATOMIC_RELAXED, __HIP_MEMORY_SCOPE_AGENT); }
__device__ __forceinline__ unsigned xb_add(unsigned* p, unsigned v) { return __hip_atomic_fetch_add(p, v, __ATOMIC_RELAXED, __HIP_MEMORY_SCOPE_AGENT); }
__device__ __forceinline__ unsigned xb_xcc_id() { return (unsigned)__builtin_amdgcn_s_getreg((3 << 11) | 20) & 0xFu; }
#define XB_SPIN(cond, bar) do { unsigned _sp = 0; while (cond) { __builtin_amdgcn_s_sleep(1); \
    if ((++_sp & 255u) == 0u) { if (xb_ld(&(bar)[XB_TMO])) break; if (_sp > XB_SPIN_CAP) { atomicAdd(&(bar)[XB_TMO], 1u); break; } } } } while (0)
struct XcdBarrier { unsigned* bar; unsigned x; volatile LAS unsigned* st; int wv; };
__device__ __forceinline__ bool xb_thread0(int wv) { return wv == 0 && __builtin_amdgcn_mbcnt_hi(~0u, __builtin_amdgcn_mbcnt_lo(~0u, 0u)) == 0u; }
__device__ __forceinline__ XcdBarrier xcd_barrier_post(unsigned* bar, volatile LAS unsigned* st, int wv) {
    XcdBarrier b; b.bar = bar; b.x = xb_xcc_id(); b.st = st; b.wv = wv;
    if (xb_thread0(wv)) (void)xb_add(&bar[XB_XCNT(b.x)], 1u);
    return b;
}
__device__ __forceinline__ void xcd_barrier_complete(unsigned* bar, unsigned x, unsigned& nloc, unsigned& nx) {
    const unsigned G = gridDim.x * gridDim.y * gridDim.z;
    unsigned sum, cnt, mine, sp = 0u;
    for (;;) {
        sum = 0u; cnt = 0u; mine = 0u;
#pragma unroll
        for (unsigned j = 0; j < 16; ++j) { const unsigned c = xb_ld(&bar[XB_XCNT(j)]); sum += c; cnt += (c > 0u) ? 1u : 0u; mine = (j == x) ? c : mine; }
        if (sum == G) break;
        __builtin_amdgcn_s_sleep(1);
        if ((++sp & 255u) == 0u) { if (xb_ld(&bar[XB_TMO])) break; if (sp > XB_SPIN_CAP) { atomicAdd(&bar[XB_TMO], 1u); break; } }
    }
    nloc = mine > 0u ? mine : 1u; nx = cnt > 0u ? cnt : 1u;
}
__device__ __forceinline__ void xcd_barrier(const XcdBarrier& b) {
    asm volatile("s_waitcnt vmcnt(0)" ::: "memory");
    __syncthreads();
    if (xb_thread0(b.wv)) {
        unsigned* bar = b.bar;
        __builtin_amdgcn_s_waitcnt(0);
        unsigned nloc = b.st[0], nx = b.st[1];
        if (nloc == 0u) { xcd_barrier_complete(bar, b.x, nloc, nx); b.st[0] = nloc; b.st[1] = nx; }
        const unsigned old = xb_add(&bar[XB_XSUB(b.x)], 1u);
        const unsigned gen = old / nloc;
        if (old + 1u == (gen + 1u) * nloc) {
            __builtin_amdgcn_fence(__ATOMIC_RELEASE, "agent");
            asm volatile("s_waitcnt vmcnt(0)" ::: "memory");
            const unsigned og = xb_add(&bar[XB_TOP], 1u);
            const unsigned tg = og / nx;
            if (og + 1u == (tg + 1u) * nx) xb_add(&bar[XB_TOPGEN], 1u);
            else XB_SPIN(xb_ld(&bar[XB_TOPGEN]) == tg, bar);
            __builtin_amdgcn_fence(__ATOMIC_ACQUIRE, "agent");
            xb_add(&bar[XB_XGEN(b.x)], 1u);
            asm volatile("s_waitcnt vmcnt(0)" ::: "memory");
        } else {
            XB_SPIN(xb_ld(&bar[XB_XGEN(b.x)]) == gen, bar);
            __builtin_amdgcn_fence(__ATOMIC_ACQUIRE, "agent");
            asm volatile("s_waitcnt vmcnt(0)" ::: "memory");
        }
    }
    __syncthreads();
}
constexpr int CW_HMC = 32768, CW_TMO = 2048;   static_assert(CW_TMO == 2048, "MoeOrder2 uses the literal");
#ifndef MOE2_PRE
#define MOE2_PRE 4
#endif
constexpr int CW_BAR = 4096;
static_assert((CW_BAR + XCD_BAR_WORDS) * 4 <= (int)CTL_BYTES, "ctl words");

using pg8::f32x4; using pg8::Unit;
struct EpiIn {
    static constexpr bool PERM = true, MIDSCALE = false;
    bf16* Z; bf16* U; bf16* SG;
    __device__ __forceinline__ void operator()(const f32x4 (&acc)[2][2][4][2], const Unit& u, int, int wr, int wc, int fr, int fq) const {
        const int row0 = u.pm * 256 + wr * 64 + fr, cb = (u.pn & 7) * 128 + wc * 32 + 8 * fq;
#pragma unroll
        for (int ai = 0; ai < 2; ++ai)
#pragma unroll
            for (int m = 0; m < 4; ++m) {
                const int row = row0 + ai * 128 + m * 16;
                float v[8], s[8];
#pragma unroll
                for (int n = 0; n < 2; ++n)
#pragma unroll
                    for (int j = 0; j < 4; ++j) { v[n * 4 + j] = acc[ai][0][m][n][j]; s[n * 4 + j] = sigmoidf_(acc[ai][1][m][n][j]); }
                if (u.pn < 8) {
                    v4u w; w.x = pk2(v[0] * s[0], v[1] * s[1]); w.y = pk2(v[2] * s[2], v[3] * s[3]); w.z = pk2(v[4] * s[4], v[5] * s[5]); w.w = pk2(v[6] * s[6], v[7] * s[7]);
                    *(v4u*)(Z + (size_t)row * CCH + cb) = w;
                } else {
                    const int b = row >> 11, t = row & (SEQ - 1), g = cb >> 4, h0 = cb & 15;
                    const size_t o = (((size_t)b * NG + g) * SEQ + t) * GW + h0;
                    v4u w; w.x = pk2(v[0], v[1]); w.y = pk2(v[2], v[3]); w.z = pk2(v[4], v[5]); w.w = pk2(v[6], v[7]);
                    v4u q; q.x = pk2(s[0], s[1]); q.y = pk2(s[2], s[3]); q.z = pk2(s[4], s[5]); q.w = pk2(s[6], s[7]);
                    *(v4u*)(U + o) = w; *(v4u*)(SG + o) = q;
                }
            }
    }
};
struct EpiOut {
    static constexpr bool PERM = true, MIDSCALE = true;
    bf16* xb; const float* gate1;
    const LAS float* rs;
    __device__ __forceinline__ void midscale(f32x4 (&acc)[2][2][4][2], int ui, int wr, int fr) const {
#pragma unroll
        for (int ai = 0; ai < 2; ++ai)
#pragma unroll
            for (int m = 0; m < 4; ++m) { const float r = rs[ui * 256 + ai * 128 + wr * 64 + m * 16 + fr];
#pragma unroll
                for (int bj = 0; bj < 2; ++bj)
#pragma unroll
                    for (int n = 0; n < 2; ++n) acc[ai][bj][m][n] *= r; }
    }
    __device__ __forceinline__ void operator()(const f32x4 (&acc)[2][2][4][2], const Unit& u, int, int wr, int wc, int fr, int fq) const {
        const int row0 = u.pm * 256 + wr * 64 + fr, col0 = u.pn * 256 + wc * 32 + 8 * fq;
        const float* g1 = gate1 + (size_t)(row0 >> 11) * 6 * D + col0;
        f32x4 gv[2][2];
#pragma unroll
        for (int bj = 0; bj < 2; ++bj)
#pragma unroll
            for (int n = 0; n < 2; ++n) gv[bj][n] = *(const f32x4*)(g1 + bj * 128 + n * 4);
#pragma unroll
        for (int ai = 0; ai < 2; ++ai) {
            v4u xv[4][2];
#pragma unroll
            for (int m = 0; m < 4; ++m) { const bf16* rp = xb + (size_t)(row0 + ai * 128 + m * 16) * D + col0; xv[m][0] = *(const v4u*)rp; xv[m][1] = *(const v4u*)(rp + 128); }
            __builtin_amdgcn_sched_barrier(0);
#pragma unroll
            for (int m = 0; m < 4; ++m) { bf16* rp = xb + (size_t)(row0 + ai * 128 + m * 16) * D + col0;
#pragma unroll
                for (int bj = 0; bj < 2; ++bj) { const f32x4 a0 = gv[bj][0] * acc[ai][bj][m][0], a1 = gv[bj][1] * acc[ai][bj][m][1]; const v4u x = xv[m][bj];
                    v4u o; o.x = pk2(__uint_as_float(x.x << 16) + a0[0], __uint_as_float(x.x & 0xffff0000u) + a0[1]); o.y = pk2(__uint_as_float(x.y << 16) + a0[2], __uint_as_float(x.y & 0xffff0000u) + a0[3]);
                    o.z = pk2(__uint_as_float(x.z << 16) + a1[0], __uint_as_float(x.z & 0xffff0000u) + a1[1]); o.w = pk2(__uint_as_float(x.w << 16) + a1[2], __uint_as_float(x.w & 0xffff0000u) + a1[3]);
                    *(v4u*)(rp + bj * 128) = o; } }
            __builtin_amdgcn_sched_barrier(0);
        }
    }
};
struct EpiMoe1 {
    static constexpr bool PERM = true, MIDSCALE = false;
    bf16* HM; int hoff;
    __device__ __forceinline__ void operator()(const f32x4 (&acc)[2][2][4][2], const Unit& u, int, int wr, int wc, int fr, int fq) const {
        const int row0 = u.pm * 256 + wr * 64 + fr, cb = (u.pn & 3) * 128 + wc * 32 + 8 * fq;
#pragma unroll
        for (int ai = 0; ai < 2; ++ai)
#pragma unroll
            for (int m = 0; m < 4; ++m) {
                float v[8];
#pragma unroll
                for (int n = 0; n < 2; ++n)
#pragma unroll
                    for (int j = 0; j < 4; ++j) v[n * 4 + j] = siluf_(acc[ai][0][m][n][j]) * acc[ai][1][m][n][j];
                v4u w; w.x = pk2(v[0], v[1]); w.y = pk2(v[2], v[3]); w.z = pk2(v[4], v[5]); w.w = pk2(v[6], v[7]);
                bf16* p = HM + (size_t)(row0 + ai * 128 + m * 16) * FF + cb;
                asm volatile("global_store_dwordx4 %0, %1, off sc1\n\ts_nop 3" :: "v"(p), "v"(w) : "memory");
            }
        asm volatile("s_waitcnt vmcnt(0)" ::: "memory");
        if ((fr | fq) == 0) (void)__hip_atomic_fetch_add(ctl_words() + hoff + 64 * u.pm, 1u, __ATOMIC_RELAXED, __HIP_MEMORY_SCOPE_AGENT);
    }
};
struct EpiMoe2 {
    static constexpr bool PERM = true, MIDSCALE = false;
    bf16* Y; const LAS unsigned* ent; const LAS float* wt;
    __device__ __forceinline__ void operator()(const f32x4 (&acc)[2][2][4][2], const Unit& u, int ui, int wr, int wc, int fr, int fq) const {
        const int cb = (u.pn & 7) * 256 + wc * 32 + 8 * fq;
#pragma unroll
        for (int ai = 0; ai < 2; ++ai)
#pragma unroll
            for (int m = 0; m < 4; ++m) {
                const int rl = ui * 256 + ai * 128 + wr * 64 + m * 16 + fr;
                const unsigned en = ent[rl]; const float w = wt[rl];
                if (en != ~0u) {
                    bf16* yr = Y + ((size_t)(en & 1u) * T + (en >> 1)) * D + cb;
#pragma unroll
                    for (int bj = 0; bj < 2; ++bj) { const f32x4 a0 = acc[ai][bj][m][0] * w, a1 = acc[ai][bj][m][1] * w;
                        v4u o; o.x = pk2(a0[0], a0[1]); o.y = pk2(a0[2], a0[3]); o.z = pk2(a1[0], a1[1]); o.w = pk2(a1[2], a1[3]);
                        *(v4u*)(yr + bj * 128) = o; }
                }
            }
    }
};

struct Frame {
    LAS unsigned char* lds;
    int vcu, G, wv;
};
__device__ __forceinline__ int fresh_tid(int wv) { int t = wv * 64 + (int)__builtin_amdgcn_mbcnt_hi(~0u, __builtin_amdgcn_mbcnt_lo(~0u, 0u)); asm volatile("" : "+v"(t)); return t; }
__device__ __forceinline__ int fresh_wave(int wv) { asm volatile("" : "+s"(wv)); return wv; }
#define PHASE_IDS const int wave = fresh_wave(F.wv), tid = fresh_tid(wave), lane = tid & 63; (void)lane
typedef __attribute__((address_space(4))) const Ptrs* KPtr;
__device__ __forceinline__ KPtr kp() { KPtr a = (KPtr)__builtin_amdgcn_kernarg_segment_ptr(); asm volatile("" : "+s"(a)); return a; }
#define KP (kp())
__device__ __forceinline__ unsigned* ctl_words() { return (unsigned*)(KP->ws + WS_CTL); }

struct P0Tile { const float* src; bf16* dst; int ld, K; };
__device__ __forceinline__ void p0_load(const P0Tile& t, f32x4 (&v)[16], int lane) {
    const float* s = t.src + (size_t)(16 * (lane >> 4)) * t.ld + 4 * (lane & 15);
#pragma unroll
    for (int i = 0; i < 16; ++i) v[i] = __builtin_nontemporal_load((const f32x4*)(s + (size_t)i * t.ld));
}
__device__ __forceinline__ void p0_store(const P0Tile& t, const f32x4 (&v)[16], LAS unsigned char* scr, int lane) {
#pragma unroll
    for (int j = 0; j < 4; ++j) {
        v4u a, b2;
        a.x = pk2(v[0][j], v[1][j]); a.y = pk2(v[2][j], v[3][j]); a.z = pk2(v[4][j], v[5][j]); a.w = pk2(v[6][j], v[7][j]);
        b2.x = pk2(v[8][j], v[9][j]); b2.y = pk2(v[10][j], v[11][j]); b2.z = pk2(v[12][j], v[13][j]); b2.w = pk2(v[14][j], v[15][j]);
        LAS unsigned char* r = scr + (4 * (lane & 15) + j) * 144 + 32 * (lane >> 4);
        *(LAS v4u*)r = a; *(LAS v4u*)(r + 16) = b2;
    }
    LDS_WAIT(); asm volatile("" ::: "memory");
#pragma unroll
    for (int q = 0; q < 8; ++q) { const int n = 8 * q + (lane >> 3); const v4u o = *(const LAS v4u*)(scr + n * 144 + 16 * (lane & 7));
        __builtin_nontemporal_store(o, (v4u*)(t.dst + (size_t)n * t.K + 8 * (lane & 7))); }
    LDS_WAIT(); asm volatile("" ::: "memory");
}
constexpr int P0_IT_WIN = NL * (INC / 64) * (D / 64);
constexpr int P0_IT_WOUT = NL * (D / 64) * (D / 64);
constexpr int P0_IT_GU = NL * NE * (2 * FF / 64) * (D / 64);
constexpr int P0_IT_DN = NL * NE * (D / 64) * (FF / 64);
constexpr int P0_ITEMS = P0_IT_WIN + P0_IT_WOUT + P0_IT_GU + P0_IT_DN;
__device__ __forceinline__ void p0_nbkb(int r, int KBt, int& nb, int& kb) { nb = r / KBt; kb = r % KBt; }
__device__ __forceinline__ P0Tile p0_tile_of(int it) {
    unsigned char* ws = KP->ws; P0Tile t; int nb, kb;
    if (it < P0_IT_WIN) {
        const int l = it / (P0_IT_WIN / NL), r = it % (P0_IT_WIN / NL); p0_nbkb(r, D / 64, nb, kb);
        const int n0 = nb * 64, pn = n0 >> 8, w = n0 & 255, half = w >> 7, j = w & 127;
        const int sc = (pn < 8 ? 0 : 2048) + half * 1024 + (pn & 7) * 128 + j;
        t.src = KP->w_in + (size_t)l * D * INC + (size_t)(kb * 64) * INC + sc; t.ld = INC; t.dst = (bf16*)(ws + WS_WIN) + ((size_t)l * INC + n0) * D + kb * 64; t.K = D;
        return t;
    }
    it -= P0_IT_WIN;
    if (it < P0_IT_WOUT) {
        const int l = it / (P0_IT_WOUT / NL), r = it % (P0_IT_WOUT / NL); p0_nbkb(r, D / 64, nb, kb);
        const int k0 = kb * 64, sk = (k0 < SCH) ? k0 + CCH : k0 - SCH;
        t.src = KP->w_out + (size_t)l * D * D + (size_t)sk * D + nb * 64; t.ld = D; t.dst = (bf16*)(ws + WS_WOUT) + ((size_t)l * D + nb * 64) * D + k0; t.K = D;
        return t;
    }
    it -= P0_IT_WOUT;
    if (it < P0_IT_GU) {
        const int le = it / 512, r = it % 512; p0_nbkb(r, D / 64, nb, kb);
        const int n0 = nb * 64, pn = n0 >> 8, w = n0 & 255, half = w >> 7, j = w & 127, f0 = pn * 128 + j;
        t.src = (half ? KP->w_up : KP->w_gate) + (size_t)le * D * FF + (size_t)(kb * 64) * FF + f0; t.ld = FF; t.dst = (bf16*)(ws + WS_GU) + ((size_t)le * 2 * FF + n0) * D + kb * 64; t.K = D;
        return t;
    }
    it -= P0_IT_GU;
    {
        const int le = it / 256, r = it % 256; p0_nbkb(r, FF / 64, nb, kb);
        t.src = KP->w_down + (size_t)le * FF * D + (size_t)(kb * 64) * D + nb * 64; t.ld = D; t.dst = (bf16*)(ws + WS_DN) + ((size_t)le * D + nb * 64) * FF + kb * 64; t.K = FF;
    }
    return t;
}
__device__ __forceinline__ void p0_mod_item(Frame& F, int item) {
    PHASE_IDS;
    const int l = item / 96, cbk = item % 96, col = cbk * 128 + 2 * lane;
    LAS float* ca = (LAS float*)F.lds;
    LAS float* red = (LAS float*)(F.lds + 65536);
    for (int i = tid; i < NB * D; i += NTHR) { const int b = i / D, k = i % D; ca[k * 8 + b] = siluf_(KP->c[i]); }
    __syncthreads();
    float a0[8], a1[8];
#pragma unroll
    for (int b = 0; b < 8; ++b) { a0[b] = 0.f; a1[b] = 0.f; }
    const float* w = KP->w_ada + (size_t)l * D * 6 * D + (size_t)(wave * 256) * 6 * D + col;
#pragma unroll 32
    for (int k = 0; k < 256; ++k) {
        const f32x2v wv_ = __builtin_nontemporal_load((const f32x2v*)(w + (size_t)k * 6 * D)); const float2 wv = {wv_.x, wv_.y};
        const f32x4 c0 = *(const LAS f32x4*)(ca + (wave * 256 + k) * 8), c1 = *(const LAS f32x4*)(ca + (wave * 256 + k) * 8 + 4);
#pragma unroll
        for (int b = 0; b < 4; ++b) { a0[b] += c0[b] * wv.x; a1[b] += c0[b] * wv.y; a0[4 + b] += c1[b] * wv.x; a1[4 + b] += c1[b] * wv.y; }
    }
#pragma unroll
    for (int b = 0; b < 8; ++b) { red[(wave * 8 + b) * 128 + 2 * lane] = a0[b]; red[(wave * 8 + b) * 128 + 2 * lane + 1] = a1[b]; }
    __syncthreads();
    for (int o = tid; o < 8 * 128; o += NTHR) { const int b = o >> 7, cc = o & 127; float s = KP->b_ada[l * 6 * D + cbk * 128 + cc];
#pragma unroll
        for (int wv = 0; wv < 8; ++wv) s += red[(wv * 8 + b) * 128 + cc];
        ((float*)(KP->ws + WS_MOD))[((size_t)l * NB + b) * 6 * D + cbk * 128 + cc] = s; }
    __syncthreads();
}
constexpr int RW_FRAGS = NL * 64 * 3;
__device__ __forceinline__ void p0_router_frag(Frame& F, int fi, int lane);
__device__ __forceinline__ void p0_ssm_mats(Frame& F, int lg);
constexpr int P0_FIRST = P0_IT_WIN / NL;
constexpr int CW_P0Q = 1536;
constexpr int G1_SPLIT = 160;
__device__ __forceinline__ void p0_prologue(Frame& F) {
    if ((int)blockIdx.x < 192) p0_mod_item(F, blockIdx.x);
    for (int lg = F.G - 1 - (int)blockIdx.x; lg < NL * NG; lg += F.G) p0_ssm_mats(F, lg);
    PHASE_IDS;
    LAS unsigned char* scr = F.lds + wave * 9216;
    const int gw = F.vcu * NWAVES + wave, NGW = F.G * NWAVES;
#pragma unroll 1
    for (int it = gw; it < P0_FIRST; it += NGW) { f32x4 va[16]; const P0Tile ta = p0_tile_of(it); p0_load(ta, va, lane); p0_store(ta, va, scr, lane); }
    for (int fi = gw; fi < RW_FRAGS; fi += NGW) p0_router_frag(F, fi, lane);
}
__device__ __forceinline__ void p0_queue(Frame& F) {
    PHASE_IDS;
    LAS unsigned char* scr = F.lds + wave * 9216;
    unsigned* cur = ctl_words() + CW_P0Q;
#pragma unroll 1
    for (;;) {
        unsigned q = 0u;
        if (lane == 0) q = __hip_atomic_fetch_add(cur, 4u, __ATOMIC_RELAXED, __HIP_MEMORY_SCOPE_AGENT);
        const int it0 = P0_FIRST + (int)__builtin_amdgcn_readfirstlane(q);
        if (it0 >= P0_ITEMS) break;
#pragma unroll 1
        for (int it = it0; it < it0 + 4 && it < P0_ITEMS; ++it) { f32x4 va[16]; const P0Tile ta = p0_tile_of(it); p0_load(ta, va, lane); p0_store(ta, va, scr, lane); }
    }
    __syncthreads();
}


template <int MODE  , bool has_y>
__device__ __forceinline__ void pn_rows(Frame& F, int l, const float* xin, int lp) {
    unsigned char* ws = KP->ws;
    const float* mod = (const float*)(ws + WS_MOD);
    PHASE_IDS;
    const int row0 = F.vcu * 64 + wave * 8, b = (F.vcu * 64) >> 11;
    LAS f32x4* Lg = (LAS f32x4*)F.lds;
    LAS f32x4* Lsh = Lg + 512;
    LAS f32x4* Lg2 = Lg + 1024;
    {
        const int i = tid;
        if (MODE == 0) { const f32x4 g = ((const f32x4*)(KP->norm1_g + l * D))[i]; const f32x4* sh = (const f32x4*)(mod + ((size_t)l * NB + b) * 6 * D); Lg[i] = g * (1.f + sh[D / 4 + i]); Lsh[i] = sh[i]; }
        else Lg[i] = ((const f32x4*)KP->final_g)[i];
        if (has_y) Lg2[i] = ((const f32x4*)(mod + ((size_t)lp * NB + b) * 6 * D + 5 * D))[i];
    }
    __syncthreads();
    f32x4 xa[has_y ? 1 : 8], xb[has_y ? 1 : 8]; v2u ra[has_y ? 8 : 1], rb[has_y ? 8 : 1], ya0[has_y ? 8 : 1], ya1[has_y ? 8 : 1], yb0[has_y ? 8 : 1], yb1[has_y ? 8 : 1], da[1], db[1];
#define PN_LOAD(XF, XR, Y0, Y1, DD, row) do { \
        if constexpr (!has_y) { const f32x4* xr_ = (const f32x4*)(xin + (size_t)(row) * D) + lane; _Pragma("unroll") for (int j = 0; j < 8; ++j) XF[j] = __builtin_nontemporal_load(xr_ + 64 * j); } \
        else { const v2u* x_ = (const v2u*)((const bf16*)(ws + WS_XB) + (size_t)(row) * D) + lane; const v2u* y0_ = (const v2u*)((const bf16*)(ws + WS_Y) + (size_t)(row) * D) + lane; const v2u* y1_ = (const v2u*)((const bf16*)(ws + WS_Y) + ((size_t)T + (row)) * D) + lane; \
            _Pragma("unroll") for (int j = 0; j < 8; ++j) { XR[j] = __builtin_nontemporal_load(x_ + 64 * j); Y0[j] = __builtin_nontemporal_load(y0_ + 64 * j); Y1[j] = __builtin_nontemporal_load(y1_ + 64 * j); } } } while (0)
#define PN_PROC(XF, XR, Y0, Y1, DD, row) do { f32x4 X[8]; \
        if constexpr (!has_y) { _Pragma("unroll") for (int j = 0; j < 8; ++j) X[j] = XF[j]; } \
        else { _Pragma("unroll") for (int j = 0; j < 8; ++j) { const v2u x = XR[j], a = Y0[j], c = Y1[j]; const f32x4 g = Lg2[64 * j + lane]; \
            X[j][0] = __uint_as_float(x.x << 16) + g[0] * (__uint_as_float(a.x << 16) + __uint_as_float(c.x << 16)); X[j][1] = __uint_as_float(x.x & 0xffff0000u) + g[1] * (__uint_as_float(a.x & 0xffff0000u) + __uint_as_float(c.x & 0xffff0000u)); \
            X[j][2] = __uint_as_float(x.y << 16) + g[2] * (__uint_as_float(a.y << 16) + __uint_as_float(c.y << 16)); X[j][3] = __uint_as_float(x.y & 0xffff0000u) + g[3] * (__uint_as_float(a.y & 0xffff0000u) + __uint_as_float(c.y & 0xffff0000u)); } } \
        __builtin_amdgcn_sched_barrier(0); \
        if (MODE == 0) { v2u* xo_ = (v2u*)((bf16*)(ws + WS_XB) + (size_t)(row) * D) + lane; _Pragma("unroll") for (int j = 0; j < 8; ++j) { v2u o; o.x = pk2(X[j][0], X[j][1]); o.y = pk2(X[j][2], X[j][3]); __builtin_nontemporal_store(o, xo_ + 64 * j); } } \
        float ss_ = 0.f; _Pragma("unroll") for (int j = 0; j < 8; ++j) ss_ += (X[j][0] * X[j][0] + X[j][1] * X[j][1]) + (X[j][2] * X[j][2] + X[j][3] * X[j][3]); \
        const float rstd_ = 1.f / sqrtf(wave_sum(ss_) * (1.f / D) + EPS); \
        __builtin_amdgcn_sched_barrier(0); \
        if (MODE == 2) { f32x4* o_ = (f32x4*)(KP->out + (size_t)(row) * D) + lane; _Pragma("unroll") for (int j = 0; j < 8; ++j) __builtin_nontemporal_store(X[j] * rstd_ * Lg[64 * j + lane], o_ + 64 * j); } \
        else { v2u* H_ = (v2u*)((bf16*)(ws + WS_H) + (size_t)(row) * D) + lane; \
            _Pragma("unroll") for (int j = 0; j < 8; ++j) { const f32x4 h = X[j] * rstd_ * Lg[64 * j + lane] + Lsh[64 * j + lane]; v2u o; o.x = pk2(h[0], h[1]); o.y = pk2(h[2], h[3]); H_[64 * j] = o; } } } while (0)
    PN_LOAD(xa, ra, ya0, ya1, da, row0);
#pragma unroll 1
    for (int r = 0; r < 8; r += 2) {
        PN_LOAD(xb, rb, yb0, yb1, db, row0 + r + 1); __builtin_amdgcn_sched_barrier(0);
        PN_PROC(xa, ra, ya0, ya1, da, row0 + r); __builtin_amdgcn_sched_barrier(0);
        if (r + 2 < 8) PN_LOAD(xa, ra, ya0, ya1, da, row0 + r + 2);
        __builtin_amdgcn_sched_barrier(0);
        PN_PROC(xb, rb, yb0, yb1, db, row0 + r + 1); __builtin_amdgcn_sched_barrier(0);
    }
#undef PN_LOAD
#undef PN_PROC
    __syncthreads();
}

__device__ __forceinline__ void p0_router_frag(Frame& F, int fi, int lane) {
    const int l = fi / 192, r = fi % 192, ks = r / 3, cb = r % 3;
    const int col = cb * 16 + (lane & 15), k0 = ks * 32 + 8 * (lane >> 4);
    f16x8 h;
#pragma unroll
    for (int q = 0; q < 8; ++q) { const int k = k0 + q;
        const float w = (col < 4) ? KP->rg_w[((size_t)l * D + k) * NGR + col] : (col < 36) ? KP->re_w[(((size_t)l * NGR + ((col - 4) >> 3)) * D + k) * EPG + ((col - 4) & 7)] : 0.f;
        h[q] = (_Float16)w; }
    ((v4u*)(KP->ws + WS_RW))[(size_t)fi * 64 + lane] = __builtin_bit_cast(v4u, h);
}

constexpr int PN2_TS = 2052;
__device__ __forceinline__ void pn2_phase(Frame& F, int l, bool commit) {
    unsigned char* ws = KP->ws;
    const float* mod = (const float*)(ws + WS_MOD);
    PHASE_IDS;
    LAS float* tile = (LAS float*)F.lds;
    LAS f32x4* Lg = (LAS f32x4*)(F.lds + 16 * PN2_TS * 4);
    LAS f32x4* Lsh = Lg + 512;
    LAS int* lcnt = (LAS int*)(F.lds + L_CNT);
    LAS int* lbase = (LAS int*)(F.lds + L_PTILE);
    LAS int* ent = (LAS int*)(F.lds + L_TAB);
    const int rowbase = F.vcu * 64;
    LAS float* rbias = (LAS float*)(F.lds + 16 * PN2_TS * 4 + 16384);
    v2u xa[2][8], xb[2][8];
#define PN2_LOAD(blk_, p_) do { const int ln_ = fresh_tid(F.wv) & 63; const v2u* xr_ = (const v2u*)((const bf16*)(ws + WS_XB) + (size_t)(rowbase + (blk_) * 16 + 2 * wave) * D) + ln_; \
        _Pragma("unroll") for (int j = 0; j < 8; ++j) { xa[p_][j] = __builtin_nontemporal_load(xr_ + 64 * j); xb[p_][j] = __builtin_nontemporal_load(xr_ + D / 4 + 64 * j); } } while (0)
#define PN2_ROW(XR, r_) do { f32x4 X[8]; _Pragma("unroll") for (int j = 0; j < 8; ++j) { const v2u x = XR[j]; X[j][0] = __uint_as_float(x.x << 16); X[j][1] = __uint_as_float(x.x & 0xffff0000u); X[j][2] = __uint_as_float(x.y << 16); X[j][3] = __uint_as_float(x.y & 0xffff0000u); } \
        float ss_ = 0.f; _Pragma("unroll") for (int j = 0; j < 8; ++j) ss_ += (X[j][0] * X[j][0] + X[j][1] * X[j][1]) + (X[j][2] * X[j][2] + X[j][3] * X[j][3]); \
        const float rstd_ = 1.f / sqrtf(wave_sum(ss_) * (1.f / D) + EPS); v2u* H_ = (v2u*)((bf16*)(ws + WS_H) + (size_t)(rowbase + blk * 16 + (r_)) * D) + lane; \
        _Pragma("unroll") for (int j = 0; j < 8; ++j) { const f32x4 h = X[j] * rstd_ * Lg[64 * j + lane] + Lsh[64 * j + lane]; v2u o; o.x = pk2(h[0], h[1]); o.y = pk2(h[2], h[3]); H_[64 * j] = o; \
            *(LAS f32x4*)(tile + (r_) * PN2_TS + 256 * j + 4 * lane) = h; } } while (0)
    PN2_LOAD(0, 0); PN2_LOAD(1, 1);
    v4u bw[8][3];
    {   const v4u* rw = (const v4u*)(ws + WS_RW) + ((size_t)l * 192 + (size_t)(wave * 8) * 3) * 64 + lane;
#pragma unroll
        for (int q = 0; q < 8; ++q)
#pragma unroll
            for (int cb = 0; cb < 3; ++cb) bw[q][cb] = rw[(size_t)(q * 3 + cb) * 64]; }
    {
        const int b = rowbase >> 11; const f32x4 g = ((const f32x4*)(KP->norm2_g + l * D))[tid]; const f32x4* sh = (const f32x4*)(mod + ((size_t)l * NB + b) * 6 * D + 3 * D);
        Lg[tid] = g * (1.f + sh[D / 4 + tid]); Lsh[tid] = sh[tid];
        if (tid < NE) lcnt[tid] = 0;
        if (tid < 36) rbias[tid] = (tid < 4) ? KP->rg_b[l * NGR + tid] : KP->re_b[l * NGR * EPG + tid - 4];
    }
    __syncthreads();
#pragma unroll
    for (int blk = 0; blk < 4; ++blk) {
        PN2_ROW(xa[blk & 1], 2 * wave); __builtin_amdgcn_sched_barrier(0);
        PN2_ROW(xb[blk & 1], 2 * wave + 1);
        __builtin_amdgcn_sched_barrier(0);
        if (blk + 2 < 4) PN2_LOAD(blk + 2, blk & 1);
        __builtin_amdgcn_sched_barrier(0);
        __syncthreads();
        f32x4 acc[3];
#pragma unroll
        for (int cb = 0; cb < 3; ++cb) acc[cb] = (f32x4){0.f, 0.f, 0.f, 0.f};
#pragma unroll
        for (int q = 0; q < 8; ++q) {
            const LAS float* tp = tile + (lane & 15) * PN2_TS + (wave * 8 + q) * 32 + 8 * (lane >> 4);
            const f32x4 x0 = *(const LAS f32x4*)tp, x1 = *(const LAS f32x4*)(tp + 4);
            f16x8 a_hi, a_lo;
            { const float xs[8] = {x0[0], x0[1], x0[2], x0[3], x1[0], x1[1], x1[2], x1[3]};
#pragma unroll
              for (int jj = 0; jj < 4; ++jj) { const f16x2 hp = __builtin_bit_cast(f16x2, __builtin_amdgcn_cvt_pkrtz(xs[2 * jj], xs[2 * jj + 1]));
                  const f16x2 lp = __builtin_bit_cast(f16x2, __builtin_amdgcn_cvt_pkrtz(xs[2 * jj] - (float)hp[0], xs[2 * jj + 1] - (float)hp[1]));
                  a_hi[2 * jj] = hp[0]; a_hi[2 * jj + 1] = hp[1]; a_lo[2 * jj] = lp[0]; a_lo[2 * jj + 1] = lp[1]; } }
#pragma unroll
            for (int cb = 0; cb < 3; ++cb) { const f16x8 b = __builtin_bit_cast(f16x8, bw[q][cb]);
                acc[cb] = __builtin_amdgcn_mfma_f32_16x16x32_f16(a_hi, b, acc[cb], 0, 0, 0);
                acc[cb] = __builtin_amdgcn_mfma_f32_16x16x32_f16(a_lo, b, acc[cb], 0, 0, 0); }
        }
        __builtin_amdgcn_sched_barrier(0);
        __syncthreads();
        LAS f32x4* part = (LAS f32x4*)F.lds;
#pragma unroll
        for (int cb = 0; cb < 3; ++cb) part[(wave * 3 + cb) * 64 + lane] = acc[cb];
        __syncthreads();
        LAS float* lg = (LAS float*)(F.lds + L_TAB + 2048);
        for (int o = tid; o < 16 * 36; o += NTHR) { const int row = o / 36, col = o % 36, cb = col >> 4, ln = (row >> 2) * 16 + (col & 15); float s = 0.f;
#pragma unroll
            for (int w = 0; w < 8; ++w) s += ((const LAS float*)(part + (w * 3 + cb) * 64 + ln))[row & 3];
            lg[o] = s; }
        __syncthreads();
        if (tid < 16) {
            const int row = rowbase + blk * 16 + tid; const LAS float* q = lg + tid * 36;
            float gl[4]; int gi = 0;
#pragma unroll
            for (int n = 0; n < 4; ++n) gl[n] = q[n] + rbias[n];
#pragma unroll
            for (int n = 1; n < 4; ++n) if (gl[n] > gl[gi]) gi = n;
            float den = 0.f;
#pragma unroll
            for (int n = 0; n < 4; ++n) den += expf(gl[n] - gl[gi]);
            const float gw = 1.f / den;
            float el[8];
#pragma unroll
            for (int e = 0; e < 8; ++e) el[e] = q[4 + gi * 8 + e] + rbias[4 + gi * 8 + e];
            int i1 = 0;
#pragma unroll
            for (int e = 1; e < 8; ++e) if (el[e] > el[i1]) i1 = e;
            int i2 = (i1 == 0) ? 1 : 0;
#pragma unroll
            for (int e = 0; e < 8; ++e) if (e != i1 && el[e] > el[i2]) i2 = e;
            const float e2 = expf(el[i2] - el[i1]); const float w1 = gw / (1.f + e2), w2 = gw * e2 / (1.f + e2);
            float* tw = (float*)(ws + WS_TOKW);
            *(f32x2v*)(tw + row * 2) = (f32x2v){w1, w2};
            const int ea = gi * 8 + i1, eb = gi * 8 + i2;
            const int ra = atomicAdd((int*)(lcnt + ea), 1), rb = atomicAdd((int*)(lcnt + eb), 1);
            LAS int* en = ent + (blk * 32 + 2 * tid) * 3;
            en[0] = ea; en[1] = row * 2; en[2] = ra; en[3] = eb; en[4] = row * 2 + 1; en[5] = rb;
        }
    }
    __syncthreads();
#undef PN2_LOAD
#undef PN2_ROW
    if (commit) {
    if (tid < NE) { const int c = lcnt[tid]; lbase[tid] = c ? (int)__hip_atomic_fetch_add((unsigned*)(ws + WS_CTL) + CW_CNT + l * NE + tid, (unsigned)c, __ATOMIC_RELAXED, __HIP_MEMORY_SCOPE_AGENT) : 0; }
    __syncthreads();
    if (tid < 128) { const LAS int* en = ent + tid * 3; ((unsigned*)(ws + WS_LIST))[(size_t)en[0] * T + lbase[en[0]] + en[2]] = (unsigned)en[1]; }
    }
    __syncthreads();
}

__device__ __forceinline__ void conv_tile(Frame& F, int l, int tile) {
    unsigned char* ws = KP->ws;
    PHASE_IDS;
    const int c0 = 2 * tid;
    const int row0 = tile * 32, t0 = row0 & (SEQ - 1);
    LAS float* C = (LAS float*)F.lds;
    {
        f32x2v w2[CW];
        const float* cw = KP->conv_w + (size_t)l * CW * CCH + c0;
#pragma unroll
        for (int k = 0; k < CW; ++k) w2[k] = *(const f32x2v*)(cw + k * CCH);
        const f32x2v cb = *(const f32x2v*)(KP->conv_b + l * CCH + c0);
        const bf16* Z = (const bf16*)(ws + WS_Z) + c0;
        unsigned zw[62];
#pragma unroll
        for (int i = 0; i < 62; ++i) { const int dt = i - (CW - 1); zw[i] = 0u; if (t0 + dt >= 0) zw[i] = __builtin_nontemporal_load((const unsigned*)(Z + (size_t)(row0 + dt) * CCH)); }
#pragma unroll
        for (int hh = 0; hh < 2; ++hh) {
            f32x2v z2[46];
#pragma unroll
            for (int i = 0; i < 46; ++i) z2[i] = (f32x2v){__uint_as_float(zw[hh * 16 + i] << 16), __uint_as_float(zw[hh * 16 + i] & 0xffff0000u)};
#pragma unroll
            for (int o = 0; o < 16; ++o) { f32x2v a = cb;
#pragma unroll
                for (int k = 0; k < CW; ++k) a = __builtin_elementwise_fma(w2[k], z2[o + k], a);
                *(LAS f32x2v*)(C + (hh * 16 + o) * CCH + c0) = a; }
        }
    }
    __syncthreads();
#pragma unroll
    for (int q = 0; q < 4; ++q) {
        const int tk = wave * 4 + q, row = row0 + tk;
        f32x4 v[4]; float s = 0.f;
#pragma unroll
        for (int j = 0; j < 4; ++j) { v[j] = *(const LAS f32x4*)(C + tk * CCH + 256 * j + 4 * lane); s += (v[j][0] + v[j][1]) + (v[j][2] + v[j][3]); }
        const float mu = wave_sum(s) * (1.f / CCH); float qq = 0.f;
#pragma unroll
        for (int j = 0; j < 4; ++j) { v[j] = v[j] - mu; qq += (v[j][0] * v[j][0] + v[j][1] * v[j][1]) + (v[j][2] * v[j][2] + v[j][3] * v[j][3]); }
        const float rstd = 1.f / sqrtf(wave_sum(qq) * (1.f / CCH) + EPS);
        float q2 = 0.f;
#pragma unroll
        for (int j = 0; j < 4; ++j) { const f32x4 g = *((const f32x4*)(KP->conv_ln_g + l * CCH) + 64 * j + lane), bb = *((const f32x4*)(KP->conv_ln_b + l * CCH) + 64 * j + lane);
#pragma unroll
            for (int i = 0; i < 4; ++i) { const float y = v[j][i] * rstd * g[i] + bb[i]; v[j][i] = siluf_(y); q2 += v[j][i] * v[j][i]; } }
        const float r2 = 1.f / sqrtf(wave_sum(q2) * (1.f / CCH) + EPS);
        v2u* ao = (v2u*)((bf16*)(ws + WS_AO) + (size_t)row * D + SCH) + lane;
#pragma unroll
        for (int j = 0; j < 4; ++j) { const f32x4 g = *((const f32x4*)(KP->onc_g + l * CCH) + 64 * j + lane); v2u o; o.x = pk2(v[j][0] * r2 * g[0], v[j][1] * r2 * g[1]); o.y = pk2(v[j][2] * r2 * g[2], v[j][3] * r2 * g[3]); ao[64 * j] = o; }
    }
    __syncthreads();
}


constexpr size_t SSMM_STRIDE = 256 * 1024, SSMM_WM = 192 * 1024;
__device__ __forceinline__ void p0_ssm_mats(Frame& F, int lg) {
    PHASE_IDS;
    const int l = lg / NG, g = lg % NG;
    LAS float* PWr = (LAS float*)F.lds;
    LAS float* PWi = PWr + 17 * 64;
    LAS float* BBr = PWi + 17 * 64;
    LAS float* BBi = BBr + 1024;
    LAS float* CCr = BBi + 1024;
    LAS float* CCi = CCr + 1024;
    LAS float* KT = CCi + 1024;
    LAS float* DS = KT + 4096;
    const float dt = expf(KP->log_dt[l * NG + g]);
    for (int i = tid; i < 17 * 64; i += NTHR) { const int k = i >> 6, p = i & 63; const float lr = KP->a_re[(l * NG + g) * NP + p], li = KP->a_im[(l * NG + g) * NP + p];
        const float mag = expf(lr * dt * (float)k), ang = li * dt * (float)k; PWr[i] = mag * cosf(ang); PWi[i] = mag * sinf(ang); }
    for (int i = tid; i < 1024; i += NTHR) { const int p = i >> 4, h = i & 15; const float lr = KP->a_re[(l * NG + g) * NP + p], li = KP->a_im[(l * NG + g) * NP + p];
        const float mag = expf(lr * dt), ang = li * dt, ar = mag * cosf(ang), ai = mag * sinf(ang), den = lr * lr + li * li, nr = ar - 1.f, ni = ai;
        const float fr = (nr * lr + ni * li) / den, fi = (ni * lr - nr * li) / den;
        const float br = KP->b_re[((size_t)(l * NG + g) * NP + p) * GW + h], bi = KP->b_im[((size_t)(l * NG + g) * NP + p) * GW + h];
        BBr[i] = fr * br - fi * bi; BBi[i] = fr * bi + fi * br;
        CCr[i] = KP->c_re[(size_t)(l * NG + g) * GW * NP + i]; CCi[i] = KP->c_im[(size_t)(l * NG + g) * GW * NP + i]; }
    if (tid < 16) DS[tid] = KP->ssm_d[l * SCH + g * GW + tid];
    if (tid < 64) { float* a16 = (float*)(KP->ws + WS_A16) + ((size_t)lg * NP + tid) * 2; const float lr = KP->a_re[(l * NG + g) * NP + tid], li = KP->a_im[(l * NG + g) * NP + tid];
        const float mag = expf(lr * dt * 16.f), ang = li * dt * 16.f; a16[0] = mag * cosf(ang); a16[1] = mag * sinf(ang); }
    __syncthreads();
    {
        const int k = tid >> 5, h = (tid >> 1) & 15, h0 = (tid & 1) * 8;
        float acc[8];
#pragma unroll
        for (int j = 0; j < 8; ++j) acc[j] = 0.f;
        for (int p = 0; p < 64; ++p) { const float cr = CCr[h * 64 + p], ci = CCi[h * 64 + p], pr = PWr[k * 64 + p], pi = PWi[k * 64 + p];
            const float zr = cr * pr - ci * pi, zi = cr * pi + ci * pr;
#pragma unroll
            for (int j = 0; j < 8; ++j) acc[j] += zr * BBr[p * 16 + h0 + j] - zi * BBi[p * 16 + h0 + j]; }
#pragma unroll
        for (int j = 0; j < 8; ++j) KT[(k * 16 + h) * 16 + h0 + j] = acc[j];
    }
    __syncthreads();
    v4u* tvf = (v4u*)(KP->ws + WS_SSMM + (size_t)lg * SSMM_STRIDE);
    v4u* wmf = (v4u*)(KP->ws + WS_SSMM + (size_t)lg * SSMM_STRIDE + SSMM_WM);
    const int fr = lane & 15, fq = lane >> 4;
    for (int f = wave; f < 192; f += NWAVES) {
        const int nt = f / 12, ks = f % 12, tau = nt, h = fr; float v[8];
        if (ks < 8) { const int sg = 2 * ks + (fq >> 1), h0 = 8 * (fq & 1), lag = tau - sg;
#pragma unroll
            for (int j = 0; j < 8; ++j) { float x = (lag >= 0) ? KT[(lag * 16 + h) * 16 + h0 + j] : 0.f; if (lag == 0 && h0 + j == h) x += DS[h]; v[j] = x; }
        } else { const int j0 = (ks - 8) * 32 + 8 * fq;
#pragma unroll
            for (int q = 0; q < 4; ++q) { const int p = (j0 >> 1) + q; const float cr = CCr[h * 64 + p], ci = CCi[h * 64 + p], pr = PWr[(tau + 1) * 64 + p], pi = PWi[(tau + 1) * 64 + p];
                v[2 * q] = cr * pr - ci * pi; v[2 * q + 1] = -(cr * pi + ci * pr); }
        }
        tvf[(size_t)f * 64 + lane] = (v4u){pk2(v[0], v[1]), pk2(v[2], v[3]), pk2(v[4], v[5]), pk2(v[6], v[7])};
    }
    for (int f = wave; f < 64; f += NWAVES) {
        const int nt = f >> 3, ks = f & 7, j = nt * 16 + fr, p = j >> 1, c = j & 1, sg = 2 * ks + (fq >> 1), h0 = 8 * (fq & 1); float v[8];
        const float pr = PWr[(15 - sg) * 64 + p], pi = PWi[(15 - sg) * 64 + p];
#pragma unroll
        for (int q = 0; q < 8; ++q) { const float br = BBr[p * 16 + h0 + q], bi = BBi[p * 16 + h0 + q]; v[q] = c ? (pr * bi + pi * br) : (pr * br - pi * bi); }
        wmf[(size_t)f * 64 + lane] = (v4u){pk2(v[0], v[1]), pk2(v[2], v[3]), pk2(v[4], v[5]), pk2(v[6], v[7])};
    }
    __syncthreads();
}

constexpr int SSM_RS = 528;
__device__ __forceinline__ void ssm_unit(Frame& F, int l, int b, int g) {
    PHASE_IDS;
    unsigned char* ws = KP->ws;
    const int fr = lane & 15, fq = lane >> 4, lg = l * NG + g;
    const int ntl = wave, nth = 15 - wave, kl = ntl >> 1, kh = nth >> 1;
    LAS unsigned char* Al = F.lds;
    LAS unsigned char* El = F.lds + 128 * SSM_RS;
    const v4u* tvf = (const v4u*)(ws + WS_SSMM + (size_t)lg * SSMM_STRIDE) + lane;
    const v4u* wmf = (const v4u*)(ws + WS_SSMM + (size_t)lg * SSMM_STRIDE + SSMM_WM) + lane;
    v4u w1[8], tl[4], th[8], sl[4], sh[4];
#pragma unroll
    for (int ks = 0; ks < 8; ++ks) w1[ks] = wmf[(size_t)(wave * 8 + ks) * 64];
#pragma unroll
    for (int ks = 0; ks < 4; ++ks) { tl[ks] = (v4u){0u, 0u, 0u, 0u}; if (ks <= kl) tl[ks] = tvf[(size_t)(ntl * 12 + ks) * 64]; }
#pragma unroll
    for (int ks = 0; ks < 8; ++ks) { th[ks] = (v4u){0u, 0u, 0u, 0u}; if (ks <= kh) th[ks] = tvf[(size_t)(nth * 12 + ks) * 64]; }
#pragma unroll
    for (int ks = 0; ks < 4; ++ks) { sl[ks] = tvf[(size_t)(ntl * 12 + 8 + ks) * 64]; sh[ks] = tvf[(size_t)(nth * 12 + 8 + ks) * 64]; }
    {
        const v4u* src = (const v4u*)((const bf16*)(ws + WS_U) + ((size_t)b * NG + g) * SEQ * GW);
        v4u av[8];
#pragma unroll
        for (int it = 0; it < 8; ++it) av[it] = src[it * NTHR + tid];
#pragma unroll
        for (int it = 0; it < 8; ++it) { const int idx = it * NTHR + tid; *(LAS v4u*)(Al + (idx >> 5) * SSM_RS + (idx & 31) * 16) = av[it]; }
    }
    __syncthreads();
#define SSM_AFR(dst, base, koff) do { _Pragma("unroll") for (int m = 0; m < 8; ++m) dst[m] = *(const LAS bf16x8*)((base) + (m * 16 + fr) * SSM_RS + (koff)); } while (0)
    {
        f32x4 acc[8];
#pragma unroll
        for (int m = 0; m < 8; ++m) acc[m] = (f32x4){0.f, 0.f, 0.f, 0.f};
#pragma unroll
        for (int ks = 0; ks < 8; ++ks) { bf16x8 afr[8]; SSM_AFR(afr, Al, (ks * 32 + 8 * fq) * 2); const bf16x8 bfr = __builtin_bit_cast(bf16x8, w1[ks]);
#pragma unroll
            for (int m = 0; m < 8; ++m) acc[m] = __builtin_amdgcn_mfma_f32_16x16x32_bf16(bfr, afr[m], acc[m], 0, 0, 0); }
#pragma unroll
        for (int m = 0; m < 8; ++m) *(LAS f32x4*)(El + (m * 16 + fr) * SSM_RS + (wave * 16 + 4 * fq) * 4) = acc[m];
    }
    __syncthreads();
    {
        const f32x2v a16 = *(const f32x2v*)((const float*)(ws + WS_A16) + ((size_t)lg * NP + lane) * 2);
        LAS f32x2v* SE = (LAS f32x2v*)(F.lds + 2 * 128 * SSM_RS);
        f32x2v e[16];
#pragma unroll
        for (int c = 0; c < 16; ++c) e[c] = *(const LAS f32x2v*)(El + (wave * 16 + c) * SSM_RS + lane * 8);
        float lr[16], li[16]; float sr = 0.f, si = 0.f;
#pragma unroll
        for (int c = 0; c < 16; ++c) { lr[c] = sr; li[c] = si; const float nr = a16.x * sr - a16.y * si + e[c].x, ni = a16.x * si + a16.y * sr + e[c].y; sr = nr; si = ni; }
        SE[wave * 64 + lane] = (f32x2v){sr, si};
        float pr = a16.x, pi = a16.y;
#pragma unroll
        for (int q = 0; q < 4; ++q) { const float tr = pr * pr - pi * pi, ti = 2.f * pr * pi; pr = tr; pi = ti; }
        __syncthreads();
        float cr = 0.f, ci = 0.f;
        for (int v = 0; v < wave; ++v) { const f32x2v s = SE[v * 64 + lane]; const float nr = pr * cr - pi * ci + s.x, ni = pr * ci + pi * cr + s.y; cr = nr; ci = ni; }
#pragma unroll
        for (int c = 0; c < 16; ++c) { *(LAS unsigned*)(El + (wave * 16 + c) * SSM_RS + lane * 4) = pk2(lr[c] + cr, li[c] + ci);
            const float nr = a16.x * cr - a16.y * ci, ni = a16.x * ci + a16.y * cr; cr = nr; ci = ni; }
    }
    const bf16* SGp = (const bf16*)(ws + WS_SG) + ((size_t)b * NG + g) * SEQ * GW;
    v2u sgw[8][2];
#pragma unroll
    for (int m = 0; m < 8; ++m) { sgw[m][0] = *(const v2u*)(SGp + (size_t)((m * 16 + fr) * 16 + ntl) * GW + 4 * fq); sgw[m][1] = *(const v2u*)(SGp + (size_t)((m * 16 + fr) * 16 + nth) * GW + 4 * fq); }
    __syncthreads();
    {
        f32x4 acc[8][2];
#pragma unroll
        for (int m = 0; m < 8; ++m) { acc[m][0] = (f32x4){0.f, 0.f, 0.f, 0.f}; acc[m][1] = (f32x4){0.f, 0.f, 0.f, 0.f}; }
#pragma unroll
        for (int ks = 0; ks < 8; ++ks) {
            if (ks <= kh) { bf16x8 afr[8]; SSM_AFR(afr, Al, (ks * 32 + 8 * fq) * 2);
                const bf16x8 bh = __builtin_bit_cast(bf16x8, th[ks]);
#pragma unroll
                for (int m = 0; m < 8; ++m) acc[m][1] = __builtin_amdgcn_mfma_f32_16x16x32_bf16(bh, afr[m], acc[m][1], 0, 0, 0);
                if (ks < 4) { if (ks <= kl) { const bf16x8 bl = __builtin_bit_cast(bf16x8, tl[ks < 4 ? ks : 0]);
#pragma unroll
                    for (int m = 0; m < 8; ++m) acc[m][0] = __builtin_amdgcn_mfma_f32_16x16x32_bf16(bl, afr[m], acc[m][0], 0, 0, 0); } }
            }
        }
#pragma unroll
        for (int ks = 0; ks < 4; ++ks) { bf16x8 afr[8]; SSM_AFR(afr, El, (ks * 32 + 8 * fq) * 2);
            const bf16x8 bl = __builtin_bit_cast(bf16x8, sl[ks]), bh = __builtin_bit_cast(bf16x8, sh[ks]);
#pragma unroll
            for (int m = 0; m < 8; ++m) { acc[m][0] = __builtin_amdgcn_mfma_f32_16x16x32_bf16(bl, afr[m], acc[m][0], 0, 0, 0); acc[m][1] = __builtin_amdgcn_mfma_f32_16x16x32_bf16(bh, afr[m], acc[m][1], 0, 0, 0); } }
        bf16* AO = (bf16*)(ws + WS_AO); float* SSQ = (float*)(ws + WS_SSQ);
        const f32x4 gs = *(const f32x4*)(KP->ons_g + l * SCH + g * GW + 4 * fq);
#pragma unroll
        for (int m = 0; m < 8; ++m)
#pragma unroll
            for (int n = 0; n < 2; ++n) {
                const int tok = (m * 16 + fr) * 16 + (n ? nth : ntl);
                const v2u sw = sgw[m][n];
                const float s0 = __uint_as_float(sw.x << 16), s1 = __uint_as_float(sw.x & 0xffff0000u), s2 = __uint_as_float(sw.y << 16), s3 = __uint_as_float(sw.y & 0xffff0000u);
                const float v0 = gelu_tanh(acc[m][n][0]) * s0, v1 = gelu_tanh(acc[m][n][1]) * s1, v2 = gelu_tanh(acc[m][n][2]) * s2, v3 = gelu_tanh(acc[m][n][3]) * s3;
                float sq = (v0 * v0 + v1 * v1) + (v2 * v2 + v3 * v3);
                sq += shfl_xor_fresh(sq, 16); sq += shfl_xor_fresh(sq, 32);
                const size_t row = (size_t)b * SEQ + tok;
                v2u o; o.x = pk2(v0 * gs[0], v1 * gs[1]); o.y = pk2(v2 * gs[2], v3 * gs[3]);
                *(v2u*)(AO + row * D + g * GW + 4 * fq) = o;
                if (fq == 0) SSQ[row * NG + ((g >> 2) & 7) * 8 + (g >> 5) * 4 + (g & 3)] = sq;
            }
    }
#undef SSM_AFR
    __syncthreads();
}

__device__ __forceinline__ void moe_tables(Frame& F, int l) {
    LAS int* pt = (LAS int*)(F.lds + L_PTILE); LAS int* lc = (LAS int*)(F.lds + L_CNT);
    const int tq = fresh_tid(F.wv);
    if (tq < NE) lc[tq] = (int)__hip_atomic_load((const unsigned*)(KP->ws + WS_CTL) + CW_CNT + l * NE + tq, __ATOMIC_RELAXED, __HIP_MEMORY_SCOPE_AGENT);
    __syncthreads();
    if (tq == 0) { int acc = 0; for (int e = 0; e < NE; ++e) { pt[e] = acc; acc += (lc[e] + 255) >> 8; } pt[NE] = acc; }
    __syncthreads();
}

struct MArgs { Ptrs p; int ph_lo, ph_hi, use_bar, mix_mask; };
__global__ void __launch_bounds__(NTHR, 2) mega(MArgs args) {
    extern __shared__ __attribute__((aligned(16))) unsigned char lds_raw[];
    Frame F;
    F.lds = (LAS unsigned char*)lds_raw;
    F.wv = __builtin_amdgcn_readfirstlane((int)threadIdx.x >> 6);
    F.G = gridDim.x; { const int bx = blockIdx.x; F.vcu = (F.G % 8 == 0) ? (bx % 8) * (F.G / 8) + bx / 8 : bx; }
    for (int u = fresh_tid(F.wv); u < (LDS_BYTES - LCTL_OFF) / 4; u += NTHR) ((LAS unsigned*)(F.lds + LCTL_OFF))[u] = 0u;
    __syncthreads();
    XcdBarrier bar; bar.bar = (unsigned*)(KP->ws + WS_CTL) + CW_BAR; bar.x = 0; bar.st = nullptr; bar.wv = F.wv;
    if (args.use_bar) bar = xcd_barrier_post((unsigned*)(KP->ws + WS_CTL) + CW_BAR, (volatile LAS unsigned*)(F.lds + L_MISC) + 8, F.wv);
    const int lo = args.ph_lo, hi = args.ph_hi;
#ifndef PROBE_DUP
#define PROBE_DUP -1
#endif
#define DUPN(k) ((PROBE_DUP == (k)) ? PROBE_REPS : 1)
#define IN(k) (lo <= (k) && (k) < hi)
#define SEAM(k) do { if (IN(k) && IN((k) + 1)) xcd_barrier(bar); } while (0)
    for (int rep = 0; rep < DUPN(7); ++rep) { if (rep) xcd_barrier(bar);
    if (IN(0)) { p0_prologue(F); } }
    SEAM(0);
    for (int l = 0; l < NL; ++l) {
        const int pb = 1 + 7 * l;
#define WSP (KP->ws)
        for (int rep = 0; rep < DUPN(0); ++rep) { if (rep) xcd_barrier(bar);
        if (IN(pb + 0)) { if (l == 0) pn_rows<0, false>(F, l, KP->x, 0); else pn_rows<0, true>(F, l, nullptr, l - 1); } }
        SEAM(pb + 0);
        for (int rep = 0; rep < DUPN(1); ++rep) { if (rep) xcd_barrier(bar);
        if (IN(pb + 1)) {
            unsigned char* ws = WSP;
            pg8::Gemm g{(const bf16*)(ws + WS_H), (const bf16*)(ws + WS_WIN) + (size_t)l * INC * D, T, INC, D};
            const int gg = (l == 0 && F.G > G1_SPLIT) ? G1_SPLIT : F.G;
            if ((int)blockIdx.x < gg) {
                pg8::StaticOrder S; S.init(T, INC, gg, (int)blockIdx.x);
                EpiIn E{(bf16*)(ws + WS_Z), (bf16*)(ws + WS_U), (bf16*)(ws + WS_SG)};
                pg8::gemm_phase<EpiIn, pg8::StaticOrder, false, D>(F.lds, g, S, E, nullptr, F.wv);
            }
            if (l == 0) p0_queue(F);
        } }
        SEAM(pb + 1);
        for (int rep = 0; rep < DUPN(2); ++rep) { if (rep) xcd_barrier(bar);
        if (IN(pb + 2)) {
            if (args.mix_mask & 2) for (int u = (int)blockIdx.x; u < ((PROBE_DUP == 21) ? PROBE_REPS : 1) * NB * NG; u += F.G) {
                const int g_ = ((u & 7) << 2) + ((u & 8) << 2) + ((u >> 4) & 3), b_ = ((u >> 6) & 3) + (((u >> 8) & 1) << 2);
                ssm_unit(F, l, b_, g_); }
            if (args.mix_mask & 1) for (int tl = F.vcu; tl < ((PROBE_DUP == 20) ? PROBE_REPS : 1) * (T / 32); tl += F.G) conv_tile(F, l, tl % (T / 32));
        } }
        SEAM(pb + 2);
        for (int rep = 0; rep < DUPN(3); ++rep) { if (rep) xcd_barrier(bar);
        if (IN(pb + 3)) {
            unsigned char* ws = WSP;
            pg8::StaticOrder S; S.init(T, D, F.G, (int)blockIdx.x);
            LAS float* rs = (LAS float*)(F.lds + L_TAB);
            {
                pg8::Unit u0, u1; const bool ok0 = S.next(0, u0), ok1 = S.next(1, u1);
                const int tq = fresh_tid(F.wv), slot = tq >> 8, r = tq & 255; pg8::Unit u; u.pm = slot ? u1.pm : u0.pm;
                if (slot ? ok1 : ok0) { const f32x4* sq = (const f32x4*)((const float*)(ws + WS_SSQ) + (size_t)(u.pm * 256 + r) * NG); float s = 0.f;
#pragma unroll
                    for (int q = 0; q < 16; ++q) { const f32x4 v = sq[q]; s += (v[0] + v[1]) + (v[2] + v[3]); }
                    rs[slot * 256 + r] = 1.f / sqrtf(s * (1.f / SCH) + EPS); }
            }
            __syncthreads();
            pg8::Gemm g{(const bf16*)(ws + WS_AO), (const bf16*)(ws + WS_WOUT) + (size_t)l * D * D, T, D, D};
            EpiOut E{(bf16*)(ws + WS_XB), (const float*)(ws + WS_MOD) + (size_t)l * NB * 6 * D + 2 * D, rs};
            pg8::gemm_phase<EpiOut, pg8::StaticOrder, false, D>(F.lds, g, S, E, nullptr, F.wv);
        } }
        SEAM(pb + 3);
        for (int rep = 0; rep < DUPN(4); ++rep) { if (rep) xcd_barrier(bar);
        if (IN(pb + 4)) pn2_phase(F, l, rep == DUPN(4) - 1); }
        SEAM(pb + 4);
        for (int rep = 0; rep < DUPN(5); ++rep) { if (rep) xcd_barrier(bar);
        if (IN(pb + 5)) {
            unsigned char* ws = WSP;
            moe_tables(F, l);
            const LAS int* pt = (const LAS int*)(F.lds + L_PTILE); const LAS int* lc = (const LAS int*)(F.lds + L_CNT);
            pg8::MoeOrder S{pt, 4, F.G, F.vcu, __builtin_amdgcn_readfirstlane(pt[NE]) * 4, (PROBE_DUP == 15) ? 2 : 1};
            LAS int* tab = (LAS int*)(F.lds + L_TAB);
            {
                LAS int* sinfo = (LAS int*)(F.lds + L_CNT + 128);
#pragma unroll 1
                for (int s = 0; s < 4; ++s) { pg8::Unit u; const bool ok = S.next(s, u); if (fresh_tid(F.wv) == 0) { sinfo[2 * s] = ok ? u.e : -1; sinfo[2 * s + 1] = ok ? u.mloc : 0; } }
                __syncthreads();
                const int tq = fresh_tid(F.wv); unsigned ev[2];
#pragma unroll
                for (int j = 0; j < 2; ++j) { const int sl = (tq >> 8) + 2 * j, e = sinfo[2 * sl], idx = sinfo[2 * sl + 1] * 256 + (tq & 255); ev[j] = 0u;
                    if (e >= 0 && idx < lc[e]) ev[j] = ((const unsigned*)(ws + WS_LIST))[(size_t)e * T + idx]; }
#pragma unroll
                for (int j = 0; j < 2; ++j) tab[((tq >> 8) + 2 * j) * 256 + (tq & 255)] = (int)(ev[j] >> 1);
            }
            __syncthreads();
            pg8::Gemm g{(const bf16*)(ws + WS_H), (const bf16*)(ws + WS_GU) + (size_t)l * NE * 2 * FF * D, 0, 0, D};
            EpiMoe1 E{(bf16*)(ws + WS_HM), CW_HMC + l * 160 * 64};
            pg8::gemm_phase<EpiMoe1, pg8::MoeOrder, true, D>(F.lds, g, S, E, tab, F.wv);
        } }
#if defined(MOE_BARRIER)
        SEAM(pb + 5);
#endif
        for (int rep = 0; rep < DUPN(6); ++rep) { if (rep) xcd_barrier(bar);
        if (IN(pb + 6)) {
            unsigned char* ws = WSP;
            moe_tables(F, l);
            const LAS int* pt = (const LAS int*)(F.lds + L_PTILE); const LAS int* lc = (const LAS int*)(F.lds + L_CNT);
            const int tm_ = __builtin_amdgcn_readfirstlane(pt[NE]), r1_ = (tm_ * 4) % F.G;
#pragma unroll 1
            for (int part = 0; part < 2; ++part) {
                pg8::MoeOrder2 S{pt, 8, F.G, F.vcu, tm_ * 8, r1_, r1_ ? MOE2_PRE : 0, part};
                LAS unsigned* tent = (LAS unsigned*)(F.lds + L_TAB); LAS float* twt = (LAS float*)(F.lds + L_TAB + 7168);
                {
                    LAS int* sinfo = (LAS int*)(F.lds + L_CNT + 128);
                    unsigned* ctl = (unsigned*)(ws + WS_CTL);
                    bool any = false;
#pragma unroll 1
                    for (int s2 = 0; s2 < 8; ++s2) { pg8::Unit u; const bool ok = S.next(s2, u) && s2 < 7; any = any || ok;
                        if (fresh_tid(F.wv) == 0) { sinfo[2 * s2] = ok ? u.e : -1; sinfo[2 * s2 + 1] = ok ? u.mloc : 0; }
                        if (ok && fresh_wave(F.wv) == 0) { unsigned* w = ctl + CW_HMC + (l * 160 + u.pm) * 64; unsigned polls = 0;
                            while ((unsigned)__builtin_amdgcn_readfirstlane(__hip_atomic_load(w, __ATOMIC_RELAXED, __HIP_MEMORY_SCOPE_AGENT)) < 32u) {
                                if (++polls > (1u << 20)) { __hip_atomic_store(ctl + CW_TMO, 1u, __ATOMIC_RELAXED, __HIP_MEMORY_SCOPE_AGENT); break; }
                                __builtin_amdgcn_s_sleep(2); } } }
                    if (any && fresh_wave(F.wv) == 0) { __builtin_amdgcn_fence(__ATOMIC_ACQUIRE, "agent"); asm volatile("s_waitcnt vmcnt(0)" ::: "memory"); }
                    __syncthreads();
                    const int tq = fresh_tid(F.wv); unsigned ev[4]; float wv[4];
#pragma unroll
                    for (int j = 0; j < 4; ++j) { const int sl = (tq >> 8) + 2 * j, e = sinfo[2 * sl], idx = sinfo[2 * sl + 1] * 256 + (tq & 255); ev[j] = ~0u;
                        if (e >= 0 && idx < lc[e]) ev[j] = ((const unsigned*)(ws + WS_LIST))[(size_t)e * T + idx]; }
#pragma unroll
                    for (int j = 0; j < 4; ++j) wv[j] = (ev[j] != ~0u) ? ((const float*)(ws + WS_TOKW))[ev[j]] : 0.f;
#pragma unroll
                    for (int j = 0; j < 4; ++j) { const int sl = (tq >> 8) + 2 * j; if (sl < 7) { tent[sl * 256 + (tq & 255)] = ev[j]; twt[sl * 256 + (tq & 255)] = wv[j]; } }
                }
                __syncthreads();
                pg8::Gemm g{(const bf16*)(ws + WS_HM), (const bf16*)(ws + WS_DN) + (size_t)l * NE * D * FF, 0, 0, FF};
                EpiMoe2 E{(bf16*)(ws + WS_Y), tent, twt};
                pg8::gemm_phase<EpiMoe2, pg8::MoeOrder2, false, FF>(F.lds, g, S, E, nullptr, F.wv);
            }
        } }
        SEAM(pb + 6);
    }
    for (int rep = 0; rep < DUPN(8); ++rep) { if (rep) xcd_barrier(bar);
    if (IN(15)) pn_rows<2, true>(F, 0, nullptr, NL - 1); }
#undef WSP
#undef IN
#undef SEAM
}

extern "C" void kernel_launch(void* const* d_in, const int* in_sizes, int n_in, void* d_out, int out_size, void* d_ws, size_t ws_size, hipStream_t stream) {
    static int grid = 0;
    if (grid == 0) {
        if (n_in != 30 || ws_size < WS_END || out_size != T * D) { fprintf(stderr, "kernel_launch: unexpected n_in %d / out_size %d / ws_size %zu (need %zu)\n", n_in, out_size, ws_size, (size_t)WS_END); grid = -1; return; }
        int dev = 0, cus = 0, per_cu = 0;
        if (hipGetDevice(&dev) != hipSuccess || hipDeviceGetAttribute(&cus, hipDeviceAttributeMultiprocessorCount, dev) != hipSuccess) { grid = -1; return; }
        if (hipFuncSetAttribute((const void*)mega, hipFuncAttributeMaxDynamicSharedMemorySize, LDS_BYTES) != hipSuccess) { fprintf(stderr, "kernel_launch: hipFuncSetAttribute failed\n"); grid = -1; return; }
        if (hipOccupancyMaxActiveBlocksPerMultiprocessor(&per_cu, (const void*)mega, NTHR, LDS_BYTES) != hipSuccess || per_cu < 1) { fprintf(stderr, "kernel_launch: occupancy query reports %d workgroups per CU; nothing launched\n", per_cu); (void)hipGetLastError(); grid = -1; return; }
        if (cus != 256) { fprintf(stderr, "kernel_launch: built for 256 CUs, device has %d; nothing launched\n", cus); grid = -1; return; }
        grid = cus;
    }
    if (grid < 0) return;
    MArgs a{};
    const float** pp = (const float**)&a.p;
    for (int i = 0; i < 30; ++i) pp[i] = (const float*)d_in[i];
    a.p.out = (float*)d_out; a.p.ws = (unsigned char*)d_ws;
    a.ph_lo = 0; a.ph_hi = 16; a.use_bar = 1; a.mix_mask = 3;
    if (hipMemsetAsync((char*)d_ws + WS_CTL, 0, CTL_BYTES, stream) != hipSuccess) { fprintf(stderr, "kernel_launch: memset failed\n"); return; }
    hipLaunchKernelGGL(mega, dim3(grid), dim3(NTHR), LDS_BYTES, stream, a);
    const hipError_t le = hipPeekAtLastError();
    if (le != hipSuccess) fprintf(stderr, "kernel_launch: launch failed: %s\n", hipGetErrorName(le));
}
```

```cpp
#include <hip/hip_runtime.h>
#include <cstdio>
#include <cstdint>

constexpr int NB = 8, SEQ = 2048, D = 2048, T = NB * SEQ, NL = 2;
constexpr int CCH = 1024, SCH = 1024, CW = 31, NG = 64, GW = 16, NP = 64, INC = 4096;
constexpr int NE = 32, EPG = 8, NGR = 4, FF = 512;
constexpr float EPS = 1e-6f;

typedef unsigned short bf16;
typedef float f32x4 __attribute__((ext_vector_type(4)));
__device__ __forceinline__ float bf2f(bf16 v) { return __uint_as_float(((unsigned)v) << 16); }
__device__ __forceinline__ bf16 f2bf(float f) { unsigned u = __float_as_uint(f); return (bf16)((u + 0x7fffu + ((u >> 16) & 1u)) >> 16); }
__device__ __forceinline__ float sigmoidf_(float x) { return __builtin_amdgcn_rcpf(1.f + __expf(-x)); }
__device__ __forceinline__ float siluf_(float x) { return x * sigmoidf_(x); }
__device__ __forceinline__ float gelu_tanh(float y) { const float u = 1.5957691216057308f * (y + 0.044715f * y * y * y); return y * sigmoidf_(u); }

constexpr size_t MiB = 1u << 20;
constexpr size_t WS_CTL = 0, CTL_BYTES = 1 * MiB;
constexpr size_t WS_MOD = 1 * MiB;
constexpr size_t WS_SSMM = 2 * MiB;
constexpr size_t WS_A16 = 34 * MiB;
constexpr size_t WS_TOKE = 35 * MiB;
constexpr size_t WS_TOKW = 35 * MiB + 512 * 1024;
constexpr size_t WS_LIST = 36 * MiB;
constexpr size_t WS_SSQ = 38 * MiB;
constexpr size_t WS_RW = 42 * MiB;
constexpr size_t WS_WIN = 48 * MiB, WS_WOUT = 80 * MiB, WS_GU = 96 * MiB, WS_DN = 352 * MiB;
constexpr size_t WS_XA = 480 * MiB, WS_XB = 608 * MiB, WS_H = 736 * MiB;
constexpr size_t WS_Z = 800 * MiB, WS_U = 832 * MiB, WS_SG = 864 * MiB, WS_AO = 896 * MiB, WS_HM = 960 * MiB;
constexpr size_t WS_Y = 800 * MiB;
constexpr size_t WS_TMP = 1000 * MiB;
constexpr size_t WS_END = 1064 * MiB;
constexpr int CW_CNT = 1024;
constexpr int HM_ROWS = 2 * T + NE * 256;

struct Ptrs {
    const float *x, *c, *w_ada, *b_ada, *norm1_g, *w_in, *conv_w, *conv_b, *conv_ln_g, *conv_ln_b;
    const float *a_re, *a_im, *b_re, *b_im, *c_re, *c_im, *ssm_d, *log_dt, *onc_g, *ons_g, *w_out, *norm2_g;
    const float *rg_w, *rg_b, *re_w, *re_b, *w_gate, *w_up, *w_down, *final_g;
    float* out; unsigned char* ws;
};

#ifndef PROBE_REPS
#define PROBE_REPS 2
#endif
#ifndef PROBE_DUP
#define PROBE_DUP -1
#endif
__device__ __forceinline__ unsigned* ctl_words();
namespace pg8 {
#define PG8_LAS __attribute__((address_space(3)))
typedef unsigned short bf16_t;
typedef short bf16x8 __attribute__((ext_vector_type(8)));
typedef float f32x4 __attribute__((ext_vector_type(4)));
typedef unsigned u32x4 __attribute__((ext_vector_type(4)));
constexpr int BM = 256, BK = 64, HALF = 128, HTB = HALF * BK * 2, STAGE_BYTES = 8 * HTB, NXCD = 8, WGM = 4;

__host__ __device__ __forceinline__ int lds_byte(int r, int c) { const int st = (r >> 4) * 2 + (c >> 5), rr = r & 15, cc = c & 31, ob = rr * 64 + cc * 2; return st * 1024 + (ob ^ (((ob >> 9) & 1) << 5)); }
__host__ __device__ __forceinline__ void stage_rc(int b, int& R, int& C) { const int st = b / 1024, sb = b % 1024, swz = sb ^ (((sb >> 9) & 1) << 5); R = (st >> 1) * 16 + swz / 64; C = (st & 1) * 32 + (swz % 64) / 2; }
__host__ __device__ __forceinline__ int perm32(int rho) { const int n = rho >> 4, i = rho & 15; return 8 * (i >> 2) + 4 * n + (i & 3); }

struct Unit { int pm, pn, e, mloc; };
struct Gemm { const bf16_t* A; const bf16_t* Bt; int M, N, K; };

struct StaticOrder {
    int nM, nN, nwg, G, c;
    __device__ void init(int M, int N, int G_, int c_) { nM = M / BM; nN = N / BM; nwg = nM * nN; G = G_; c = c_; }
    __device__ bool next(int i, Unit& u) const {
        const long L = (long)i * G + c; if (L >= nwg) return false;
        int wgid = (int)L; { const int q = nwg / NXCD, r = nwg % NXCD, xcd = wgid % NXCD, off = wgid / NXCD; wgid = (xcd < r ? xcd * (q + 1) : r * (q + 1) + (xcd - r) * q) + off; }
        const int nig = WGM * nN, gid = wgid / nig, fm = gid * WGM, gsz = (nM - fm) < WGM ? (nM - fm) : WGM;
        u.pm = fm + ((wgid % nig) % gsz); u.pn = (wgid % nig) / gsz; u.e = 0; u.mloc = 0; return true;
    }
};
struct MoeOrder {
    const PG8_LAS int* ptile; int npn, G, c, total, rep;
    __device__ __forceinline__ void decode(int j, Unit& u) const {
        const int mt = j / npn, pn = j % npn;
        int ln_ = (int)__builtin_amdgcn_mbcnt_hi(~0u, __builtin_amdgcn_mbcnt_lo(~0u, 0u)); asm volatile("" : "+v"(ln_));
        const int pv = ptile[(ln_ & 31) + 1];
        const int e = __builtin_popcountll(__ballot(pv <= mt) & 0xffffffffull);
        u.pm = mt; u.pn = e * npn + pn; u.e = e; u.mloc = __builtin_amdgcn_readfirstlane(mt - ptile[e]);
    }
    __device__ bool next(int i, Unit& u) const {
        long L = (long)i * G + c; if (L >= (long)total * rep) return false;
        if (L >= total) L -= total;
        decode((int)L, u); return true;
    }
};
struct MoeOrder2 {
    const PG8_LAS int* ptile; int npn, G, c, total, r, pre, part;
    __device__ bool next(int i, Unit& u) const {
        const int preN = pre * (G - r); int j;
        if (part == 0) { if (c < r || i >= pre) return false; j = i * (G - r) + (c - r); }
        else j = preN + i * G + c;
        if (j >= total) return false;
        MoeOrder o{ptile, npn, G, c, total, 1}; o.decode(j, u); return true;
    }
};

__device__ __forceinline__ unsigned cvt_pk_bf16(float lo, float hi) { unsigned r; asm volatile("v_cvt_pk_bf16_f32 %0, %1, %2" : "=v"(r) : "v"(lo), "v"(hi)); return r; }

template <class Epi, class Sched, bool GATHER, int KC>
__device__ __forceinline__ void gemm_phase(PG8_LAS unsigned char* lds, const Gemm g, const Sched& S, const Epi& E, const PG8_LAS int* rowtab, const int wv) {
    int tid_ = wv * 64 + (int)__builtin_amdgcn_mbcnt_hi(~0u, __builtin_amdgcn_mbcnt_lo(~0u, 0u)); asm volatile("" : "+v"(tid_));
    const int tid = tid_, wid = wv, lane = tid & 63, wr = wid >> 2, wc = wid & 3, fr = lane & 15, fq = lane >> 4;
    constexpr int K = KC, nt = K / BK;
    unsigned voffA[2], voffB[2]; int Rr[2];
#pragma unroll
    for (int i = 0; i < 2; ++i) { int R, C; stage_rc(tid * 16 + i * 8192, R, C); const int Rb = Epi::PERM ? ((R & ~31) + perm32(R & 31)) : R;
        voffA[i] = GATHER ? (unsigned)(C * 2) : (unsigned)(R * K + C) * 2u; voffB[i] = (unsigned)(Rb * K + C) * 2u; Rr[i] = R; }
    constexpr size_t kstep = (size_t)(BK * 2);
    constexpr size_t hstep = (size_t)HALF * K * 2;
    constexpr size_t tstep = 2 * hstep;
    const unsigned ldsw = (unsigned)wid * 1024u;
    const int aoff = lds_byte(wr * 64 + fr, fq * 8), boff = lds_byte(wc * 32 + fr, fq * 8);
#define PG8_SA(b, h) (((b) * 2 + (h)) * HTB)
#define PG8_SB(b, h) ((4 + (b) * 2 + (h)) * HTB)
#define PG8_STAGE(bufoff, gbase, voff) do { _Pragma("unroll") for (int _i = 0; _i < 2; ++_i) \
        __builtin_amdgcn_global_load_lds((const unsigned*)((const char*)(gbase) + (voff)[_i]), (PG8_LAS unsigned*)(lds + (bufoff) + ldsw + _i * 8192), 16, 0, 0); } while (0)
#define PG8_STA(bufoff, usel, h, kb) do { if constexpr (GATHER) { unsigned _o[2]; _o[0] = (usel) ? gan[h][0] : gac[h][0]; _o[1] = (usel) ? gan[h][1] : gac[h][1]; PG8_STAGE(bufoff, gA + (kb), _o); } \
        else { PG8_STAGE(bufoff, ((usel) ? nA : cA) + (h) * hstep + (kb), voffA); } } while (0)
#define PG8_LDA(dst, b, h) do { _Pragma("unroll") for (int m = 0; m < 4; ++m) _Pragma("unroll") for (int k = 0; k < 2; ++k) dst[m][k] = *(const PG8_LAS bf16x8*)(lds + PG8_SA(b, h) + aoff + m * 2048 + k * 1024); } while (0)
#define PG8_LDB(dst, b, h) do { _Pragma("unroll") for (int n = 0; n < 2; ++n) _Pragma("unroll") for (int k = 0; k < 2; ++k) dst[n][k] = *(const PG8_LAS bf16x8*)(lds + PG8_SB(b, h) + boff + n * 2048 + k * 1024); } while (0)
#define PG8_MMA(ai, bj, At, Bt) do { __builtin_amdgcn_s_setprio(1); _Pragma("unroll") for (int m = 0; m < 4; ++m) _Pragma("unroll") for (int n = 0; n < 2; ++n) _Pragma("unroll") for (int k = 0; k < 2; ++k) \
        acc[ai][bj][m][n] = __builtin_amdgcn_mfma_f32_16x16x32_bf16(Bt[n][k], At[m][k], acc[ai][bj][m][n], 0, 0, 0); __builtin_amdgcn_s_setprio(0); } while (0)
#define PG8_WAIT_V(n) asm volatile("s_waitcnt vmcnt(" #n ")" ::: "memory")
#define PG8_WAIT_L(n) asm volatile("s_waitcnt lgkmcnt(" #n ")" ::: "memory")
#define PG8_BAR __builtin_amdgcn_s_barrier()
#define PG8_SCHED __builtin_amdgcn_sched_barrier(0)
#define PG8_GROWS(dst, slot) do { _Pragma("unroll") for (int _h = 0; _h < 2; ++_h) _Pragma("unroll") for (int _i = 0; _i < 2; ++_i) \
        dst[_h][_i] = (unsigned)rowtab[(slot) * 256 + _h * 128 + Rr[_i]] * (unsigned)(K * 2) + voffA[_i]; } while (0)
    Unit cur, nxt; int ui = 0;
    if (!S.next(0, cur)) return;
    f32x4 acc[2][2][4][2];
#pragma unroll
    for (int a = 0; a < 2; ++a)
#pragma unroll
        for (int b = 0; b < 2; ++b)
#pragma unroll
            for (int m = 0; m < 4; ++m)
#pragma unroll
                for (int n = 0; n < 2; ++n) acc[a][b][m][n] = (f32x4){0.f, 0.f, 0.f, 0.f};
    bf16x8 At[4][2], B0[2][2], B1[2][2];
    const char* const gA = (const char*)g.A;
    const char* cA = gA + (size_t)cur.pm * tstep; const char* cB = (const char*)g.Bt + (size_t)cur.pn * tstep;
    const char* nA = cA;
    unsigned gac[2][2], gan[2][2];
    if constexpr (GATHER) { PG8_GROWS(gac, 0); } else { gac[0][0] = gac[0][1] = gac[1][0] = gac[1][1] = 0u; }
#pragma unroll
    for (int h = 0; h < 2; ++h) { gan[h][0] = gac[h][0]; gan[h][1] = gac[h][1]; }
    PG8_STAGE(PG8_SB(0, 0), cB, voffB); PG8_STAGE(PG8_SB(0, 1), cB + hstep, voffB); PG8_STA(PG8_SA(0, 0), 0, 0, (size_t)0); PG8_STA(PG8_SA(0, 1), 0, 1, (size_t)0);
    if (wr == 1) PG8_BAR;
    PG8_WAIT_V(2); PG8_BAR;
    PG8_STAGE(PG8_SB(1, 0), cB + kstep, voffB); PG8_STA(PG8_SA(1, 0), 0, 0, kstep); PG8_STAGE(PG8_SB(1, 1), cB + hstep + kstep, voffB);
    PG8_WAIT_V(6); PG8_BAR;
    for (;;) {
        const bool has_next = S.next(ui + 1, nxt);
        nA = has_next ? gA + (size_t)nxt.pm * tstep : cA; const char* nB = has_next ? (const char*)g.Bt + (size_t)nxt.pn * tstep : cB;
        if constexpr (GATHER) { if (has_next) { PG8_GROWS(gan, ui + 1); } }
        for (int t = 0; t < nt; t += 2) {
            const bool last = (t == nt - 2);
            const size_t kb1 = (size_t)(t + 1) * kstep;
            const size_t kb2 = last ? (size_t)0 : (size_t)(t + 2) * kstep;
            const char* b2 = last ? nB : cB + (size_t)(t + 2) * kstep;
            const char* b3 = b2 + kstep;
            if constexpr (Epi::MIDSCALE) { if (t == nt / 2) E.midscale(acc, ui, wr, fr); }
            PG8_LDB(B0, 0, 0); PG8_LDB(B1, 0, 1); PG8_SCHED; PG8_LDA(At, 0, 0); PG8_STA(PG8_SA(1, 1), 0, 1, kb1);
            PG8_WAIT_V(8); PG8_WAIT_L(0); PG8_BAR; PG8_MMA(0, 0, At, B0); PG8_MMA(0, 1, At, B1); PG8_BAR; PG8_SCHED;
            PG8_LDA(At, 0, 1); PG8_STAGE(PG8_SB(0, 0), b2, voffB); PG8_STAGE(PG8_SB(0, 1), b2 + hstep, voffB); PG8_STA(PG8_SA(0, 0), last, 0, kb2);
            PG8_WAIT_V(8); PG8_WAIT_L(0); PG8_BAR; PG8_MMA(1, 0, At, B0); PG8_MMA(1, 1, At, B1); PG8_BAR; PG8_SCHED;
            PG8_LDB(B0, 1, 0); PG8_LDB(B1, 1, 1); PG8_SCHED; PG8_LDA(At, 1, 0); PG8_STA(PG8_SA(0, 1), last, 1, kb2);
            PG8_WAIT_V(8); PG8_WAIT_L(0); PG8_BAR; PG8_MMA(0, 0, At, B0); PG8_MMA(0, 1, At, B1); PG8_BAR; PG8_SCHED;
            PG8_LDA(At, 1, 1); PG8_STAGE(PG8_SB(1, 0), b3, voffB); PG8_STAGE(PG8_SB(1, 1), b3 + hstep, voffB); PG8_STA(PG8_SA(1, 0), last, 0, kb2 + kstep);
            PG8_WAIT_V(8); PG8_WAIT_L(0); PG8_BAR; PG8_MMA(1, 0, At, B0); PG8_MMA(1, 1, At, B1); PG8_BAR; PG8_SCHED;
        }
        if (wr == 0) PG8_BAR;
        E(acc, cur, ui, wr, wc, fr, fq);
        if (!has_next) break;
#pragma unroll
        for (int a = 0; a < 2; ++a)
#pragma unroll
            for (int b = 0; b < 2; ++b)
#pragma unroll
                for (int m = 0; m < 4; ++m)
#pragma unroll
                    for (int n = 0; n < 2; ++n) acc[a][b][m][n] = (f32x4){0.f, 0.f, 0.f, 0.f};
        cur = nxt; cA = nA; cB = nB; ++ui;
#pragma unroll
        for (int h = 0; h < 2; ++h) { gac[h][0] = gan[h][0]; gac[h][1] = gan[h][1]; }
        if (wr == 1) PG8_BAR;
    }
    PG8_WAIT_V(0);
    PG8_BAR;
#undef PG8_SA
#undef PG8_SB
#undef PG8_STAGE
#undef PG8_STA
#undef PG8_LDA
#undef PG8_LDB
#undef PG8_MMA
#undef PG8_WAIT_V
#undef PG8_WAIT_L
#undef PG8_BAR
#undef PG8_SCHED
#undef PG8_GROWS
}
}

constexpr int NWAVES = 8, NTHR = NWAVES * 64;
constexpr int SCR_BYTES = 148480;
constexpr int LCTL_OFF = SCR_BYTES;
constexpr int L_MISC = LCTL_OFF;
constexpr int L_PTILE = LCTL_OFF + 128;
constexpr int L_CNT = LCTL_OFF + 320;
constexpr int L_TAB = LCTL_OFF + 512;
constexpr int LDS_BYTES = 163840;
static_assert(L_TAB + 14336 <= LDS_BYTES, "LDS map");

#define GAS __attribute__((address_space(1)))
#define LAS __attribute__((address_space(3)))
typedef float f32x2v __attribute__((ext_vector_type(2)));
typedef unsigned v4u __attribute__((ext_vector_type(4)));
typedef unsigned v2u __attribute__((ext_vector_type(2)));
typedef short bf16x8 __attribute__((ext_vector_type(8)));
typedef _Float16 f16x8 __attribute__((ext_vector_type(8)));
typedef _Float16 f16x2 __attribute__((ext_vector_type(2)));
#define LDS_WAIT() asm volatile("s_waitcnt lgkmcnt(0)" ::: "memory")
#define VM_WAIT() asm volatile("s_waitcnt vmcnt(0)" ::: "memory")
typedef __bf16 bf16x2_hw __attribute__((ext_vector_type(2)));
__device__ __forceinline__ unsigned pk2(float lo, float hi) { const f32x2v v = {lo, hi}; const bf16x2_hw b = __builtin_convertvector(v, bf16x2_hw); return __builtin_bit_cast(unsigned, b); }
__device__ __forceinline__ float dpp_add(float v, const int ctrl_sel) {
    int x = __builtin_bit_cast(int, v), y;
    if (ctrl_sel == 0) y = __builtin_amdgcn_update_dpp(0, x, 0xB1, 0xf, 0xf, true);
    else if (ctrl_sel == 1) y = __builtin_amdgcn_update_dpp(0, x, 0x4E, 0xf, 0xf, true);
    else if (ctrl_sel == 2) y = __builtin_amdgcn_update_dpp(0, x, 0x141, 0xf, 0xf, true);
    else y = __builtin_amdgcn_update_dpp(0, x, 0x140, 0xf, 0xf, true);
    return v + __builtin_bit_cast(float, y);
}
__device__ __forceinline__ float row16_sum(float v) { v = dpp_add(v, 0); v = dpp_add(v, 1); v = dpp_add(v, 2); v = dpp_add(v, 3); return v; }
__device__ __forceinline__ float wave_sum(float v) {
    v = row16_sum(v);
    const int x = __builtin_bit_cast(int, v);
    const float r0 = __builtin_bit_cast(float, __builtin_amdgcn_readlane(x, 0)), r1 = __builtin_bit_cast(float, __builtin_amdgcn_readlane(x, 16));
    const float r2 = __builtin_bit_cast(float, __builtin_amdgcn_readlane(x, 32)), r3 = __builtin_bit_cast(float, __builtin_amdgcn_readlane(x, 48));
    return (r0 + r1) + (r2 + r3);
}
__device__ __forceinline__ float shfl_xor_fresh(float v, int mask) {
    int l = __builtin_amdgcn_mbcnt_hi(~0u, __builtin_amdgcn_mbcnt_lo(~0u, 0u)); asm volatile("" : "+v"(l));
    return __builtin_bit_cast(float, __builtin_amdgcn_ds_bpermute((l ^ mask) << 2, __builtin_bit_cast(int, v)));
}

#define XB_TMO      128
#define XB_XCNT(j)  (256  + 64 * (j))
#define XB_XSUB(j)  (1280 + 64 * (j))
#define XB_XGEN(j)  (2304 + 64 * (j))
#define XB_TOP      3328
#define XB_TOPGEN   3392
#define XCD_BAR_WORDS 3456
#define XB_SPIN_CAP (1u << 18)
__device__ __forceinline__ unsigned xb_ld(unsigned* p)              { return __hip_atomic_load(p, __ATOMIC_RELAXED, __HIP_MEMORY_SCOPE_AGENT); }
__device__ __forceinline__ unsigned xb_add(unsigned* p, unsigned v) { return __hip_atomic_fetch_add(p, v, __ATOMIC_RELAXED, __HIP_MEMORY_SCOPE_AGENT); }
__device__ __forceinline__ unsigned xb_xcc_id() { return (unsigned)__builtin_amdgcn_s_getreg((3 << 11) | 20) & 0xFu; }
#define XB_SPIN(cond, bar) do { unsigned _sp = 0; while (cond) { __builtin_amdgcn_s_sleep(1); \
    if ((++_sp & 255u) == 0u) { if (xb_ld(&(bar)[XB_TMO])) break; if (_sp > XB_SPIN_CAP) { atomicAdd(&(bar)[XB_TMO], 1u); break; } } } } while (0)
struct XcdBarrier { unsigned* bar; unsigned x; volatile LAS unsigned* st; int wv; };
__device__ __forceinline__ bool xb_thread0(int wv) { return wv == 0 && __builtin_amdgcn_mbcnt_hi(~0u, __builtin_amdgcn_mbcnt_lo(~0u, 0u)) == 0u; }
__device__ __forceinline__ XcdBarrier xcd_barrier_post(unsigned* bar, volatile LAS unsigned* st, int wv) {
    XcdBarrier b; b.bar = bar; b.x = xb_xcc_id(); b.st = st; b.wv = wv;
    if (xb_thread0(wv)) (void)xb_add(&bar[XB_XCNT(b.x)], 1u);
    return b;
}
__device__ __forceinline__ void xcd_barrier_complete(unsigned* bar, unsigned x, unsigned& nloc, unsigned& nx) {
    const unsigned G = gridDim.x * gridDim.y * gridDim.z;
    unsigned sum, cnt, mine, sp = 0u;
    for (;;) {
        sum = 0u; cnt = 0u; mine = 0u;
#pragma unroll
        for (unsigned j = 0; j < 16; ++j) { const unsigned c = xb_ld(&bar[XB_XCNT(j)]); sum += c; cnt += (c > 0u) ? 1u : 0u; mine = (j == x) ? c : mine; }
        if (sum == G) break;
        __builtin_amdgcn_s_sleep(1);
        if ((++sp & 255u) == 0u) { if (xb_ld(&bar[XB_TMO])) break; if (sp > XB_SPIN_CAP) { atomicAdd(&bar[XB_TMO], 1u); break; } }
    }
    nloc = mine > 0u ? mine : 1u; nx = cnt > 0u ? cnt : 1u;
}
__device__ __forceinline__ void xcd_barrier(const XcdBarrier& b) {
    asm volatile("s_waitcnt vmcnt(0)" ::: "memory");
    __syncthreads();
    if (xb_thread0(b.wv)) {
        unsigned* bar = b.bar;
        __builtin_amdgcn_s_waitcnt(0);
        unsigned nloc = b.st[0], nx = b.st[1];
        if (nloc == 0u) { xcd_barrier_complete(bar, b.x, nloc, nx); b.st[0] = nloc; b.st[1] = nx; }
        const unsigned old = xb_add(&bar[XB_XSUB(b.x)], 1u);
        const unsigned gen = old / nloc;
        if (old + 1u == (gen + 1u) * nloc) {
            __builtin_amdgcn_fence(__ATOMIC_RELEASE, "agent");
            asm volatile("s_waitcnt vmcnt(0)" ::: "memory");
            const unsigned og = xb_add(&bar[XB_TOP], 1u);
            const unsigned tg = og / nx;
            if (og + 1u == (tg + 1u) * nx) xb_add(&bar[XB_TOPGEN], 1u);
            else XB_SPIN(xb_ld(&bar[XB_TOPGEN]) == tg, bar);
            __builtin_amdgcn_fence(__ATOMIC_ACQUIRE, "agent");
            xb_add(&bar[XB_XGEN(b.x)], 1u);
            asm volatile("s_waitcnt vmcnt(0)" ::: "memory");
        } else {
            XB_SPIN(xb_ld(&bar[XB_XGEN(b.x)]) == gen, bar);
            __builtin_amdgcn_fence(__ATOMIC_ACQUIRE, "agent");
            asm volatile("s_waitcnt vmcnt(0)" ::: "memory");
        }
    }
    __syncthreads();
}
constexpr int CW_HMC = 32768, CW_TMO = 2048;   static_assert(CW_TMO == 2048, "MoeOrder2 uses the literal");
#ifndef MOE2_PRE
#define MOE2_PRE 4
#endif
constexpr int CW_BAR = 4096;
static_assert((CW_BAR + XCD_BAR_WORDS) * 4 <= (int)CTL_BYTES, "ctl words");

using pg8::f32x4; using pg8::Unit;
struct EpiIn {
    static constexpr bool PERM = true, MIDSCALE = false;
    bf16* Z; bf16* U; bf16* SG;
    __device__ __forceinline__ void operator()(const f32x4 (&acc)[2][2][4][2], const Unit& u, int, int wr, int wc, int fr, int fq) const {
        const int row0 = u.pm * 256 + wr * 64 + fr, cb = (u.pn & 7) * 128 + wc * 32 + 8 * fq;
#pragma unroll
        for (int ai = 0; ai < 2; ++ai)
#pragma unroll
            for (int m = 0; m < 4; ++m) {
                const int row = row0 + ai * 128 + m * 16;
                float v[8], s[8];
#pragma unroll
                for (int n = 0; n < 2; ++n)
#pragma unroll
                    for (int j = 0; j < 4; ++j) { v[n * 4 + j] = acc[ai][0][m][n][j]; s[n * 4 + j] = sigmoidf_(acc[ai][1][m][n][j]); }
                if (u.pn < 8) {
                    v4u w; w.x = pk2(v[0] * s[0], v[1] * s[1]); w.y = pk2(v[2] * s[2], v[3] * s[3]); w.z = pk2(v[4] * s[4], v[5] * s[5]); w.w = pk2(v[6] * s[6], v[7] * s[7]);
                    *(v4u*)(Z + (size_t)row * CCH + cb) = w;
                } else {
                    const int b = row >> 11, t = row & (SEQ - 1), g = cb >> 4, h0 = cb & 15;
                    const size_t o = (((size_t)b * NG + g) * SEQ + t) * GW + h0;
                    v4u w; w.x = pk2(v[0], v[1]); w.y = pk2(v[2], v[3]); w.z = pk2(v[4], v[5]); w.w = pk2(v[6], v[7]);
                    v4u q; q.x = pk2(s[0], s[1]); q.y = pk2(s[2], s[3]); q.z = pk2(s[4], s[5]); q.w = pk2(s[6], s[7]);
                    *(v4u*)(U + o) = w; *(v4u*)(SG + o) = q;
                }
            }
    }
};
struct EpiOut {
    static constexpr bool PERM = true, MIDSCALE = true;
    bf16* xb; const float* gate1;
    const LAS float* rs;
    __device__ __forceinline__ void midscale(f32x4 (&acc)[2][2][4][2], int ui, int wr, int fr) const {
#pragma unroll
        for (int ai = 0; ai < 2; ++ai)
#pragma unroll
            for (int m = 0; m < 4; ++m) { const float r = rs[ui * 256 + ai * 128 + wr * 64 + m * 16 + fr];
#pragma unroll
                for (int bj = 0; bj < 2; ++bj)
#pragma unroll
                    for (int n = 0; n < 2; ++n) acc[ai][bj][m][n] *= r; }
    }
    __device__ __forceinline__ void operator()(const f32x4 (&acc)[2][2][4][2], const Unit& u, int, int wr, int wc, int fr, int fq) const {
        const int row0 = u.pm * 256 + wr * 64 + fr, col0 = u.pn * 256 + wc * 32 + 8 * fq;
        const float* g1 = gate1 + (size_t)(row0 >> 11) * 6 * D + col0;
        f32x4 gv[2][2];
#pragma unroll
        for (int bj = 0; bj < 2; ++bj)
#pragma unroll
            for (int n = 0; n < 2; ++n) gv[bj][n] = *(const f32x4*)(g1 + bj * 128 + n * 4);
#pragma unroll
        for (int ai = 0; ai < 2; ++ai) {
            v4u xv[4][2];
#pragma unroll
            for (int m = 0; m < 4; ++m) { const bf16* rp = xb + (size_t)(row0 + ai * 128 + m * 16) * D + col0; xv[m][0] = *(const v4u*)rp; xv[m][1] = *(const v4u*)(rp + 128); }
            __builtin_amdgcn_sched_barrier(0);
#pragma unroll
            for (int m = 0; m < 4; ++m) { bf16* rp = xb + (size_t)(row0 + ai * 128 + m * 16) * D + col0;
#pragma unroll
                for (int bj = 0; bj < 2; ++bj) { const f32x4 a0 = gv[bj][0] * acc[ai][bj][m][0], a1 = gv[bj][1] * acc[ai][bj][m][1]; const v4u x = xv[m][bj];
                    v4u o; o.x = pk2(__uint_as_float(x.x << 16) + a0[0], __uint_as_float(x.x & 0xffff0000u) + a0[1]); o.y = pk2(__uint_as_float(x.y << 16) + a0[2], __uint_as_float(x.y & 0xffff0000u) + a0[3]);
                    o.z = pk2(__uint_as_float(x.z << 16) + a1[0], __uint_as_float(x.z & 0xffff0000u) + a1[1]); o.w = pk2(__uint_as_float(x.w << 16) + a1[2], __uint_as_float(x.w & 0xffff0000u) + a1[3]);
                    *(v4u*)(rp + bj * 128) = o; } }
            __builtin_amdgcn_sched_barrier(0);
        }
    }
};
struct EpiMoe1 {
    static constexpr bool PERM = true, MIDSCALE = false;
    bf16* HM; int hoff;
    __device__ __forceinline__ void operator()(const f32x4 (&acc)[2][2][4][2], const Unit& u, int, int wr, int wc, int fr, int fq) const {
        const int row0 = u.pm * 256 + wr * 64 + fr, cb = (u.pn & 3) * 128 + wc * 32 + 8 * fq;
#pragma unroll
        for (int ai = 0; ai < 2; ++ai)
#pragma unroll
            for (int m = 0; m < 4; ++m) {
                float v[8];
#pragma unroll
                for (int n = 0; n < 2; ++n)
#pragma unroll
                    for (int j = 0; j < 4; ++j) v[n * 4 + j] = siluf_(acc[ai][0][m][n][j]) * acc[ai][1][m][n][j];
                v4u w; w.x = pk2(v[0], v[1]); w.y = pk2(v[2], v[3]); w.z = pk2(v[4], v[5]); w.w = pk2(v[6], v[7]);
                bf16* p = HM + (size_t)(row0 + ai * 128 + m * 16) * FF + cb;
                asm volatile("global_store_dwordx4 %0, %1, off sc1\n\ts_nop 3" :: "v"(p), "v"(w) : "memory");
            }
        asm volatile("s_waitcnt vmcnt(0)" ::: "memory");
        if ((fr | fq) == 0) (void)__hip_atomic_fetch_add(ctl_words() + hoff + 64 * u.pm, 1u, __ATOMIC_RELAXED, __HIP_MEMORY_SCOPE_AGENT);
    }
};
struct EpiMoe2 {
    static constexpr bool PERM = true, MIDSCALE = false;
    bf16* Y; const LAS unsigned* ent; const LAS float* wt;
    __device__ __forceinline__ void operator()(const f32x4 (&acc)[2][2][4][2], const Unit& u, int ui, int wr, int wc, int fr, int fq) const {
        const int cb = (u.pn & 7) * 256 + wc * 32 + 8 * fq;
#pragma unroll
        for (int ai = 0; ai < 2; ++ai)
#pragma unroll
            for (int m = 0; m < 4; ++m) {
                const int rl = ui * 256 + ai * 128 + wr * 64 + m * 16 + fr;
                const unsigned en = ent[rl]; const float w = wt[rl];
                if (en != ~0u) {
                    bf16* yr = Y + ((size_t)(en & 1u) * T + (en >> 1)) * D + cb;
#pragma unroll
                    for (int bj = 0; bj < 2; ++bj) { const f32x4 a0 = acc[ai][bj][m][0] * w, a1 = acc[ai][bj][m][1] * w;
                        v4u o; o.x = pk2(a0[0], a0[1]); o.y = pk2(a0[2], a0[3]); o.z = pk2(a1[0], a1[1]); o.w = pk2(a1[2], a1[3]);
                        *(v4u*)(yr + bj * 128) = o; }
                }
            }
    }
};

struct Frame {
    LAS unsigned char* lds;
    int vcu, G, wv;
};
__device__ __forceinline__ int fresh_tid(int wv) { int t = wv * 64 + (int)__builtin_amdgcn_mbcnt_hi(~0u, __builtin_amdgcn_mbcnt_lo(~0u, 0u)); asm volatile("" : "+v"(t)); return t; }
__device__ __forceinline__ int fresh_wave(int wv) { asm volatile("" : "+s"(wv)); return wv; }
#define PHASE_IDS const int wave = fresh_wave(F.wv), tid = fresh_tid(wave), lane = tid & 63; (void)lane
typedef __attribute__((address_space(4))) const Ptrs* KPtr;
__device__ __forceinline__ KPtr kp() { KPtr a = (KPtr)__builtin_amdgcn_kernarg_segment_ptr(); asm volatile("" : "+s"(a)); return a; }
#define KP (kp())
__device__ __forceinline__ unsigned* ctl_words() { return (unsigned*)(KP->ws + WS_CTL); }

struct P0Tile { const float* src; bf16* dst; int ld, K; };
__device__ __forceinline__ void p0_load(const P0Tile& t, f32x4 (&v)[16], int lane) {
    const float* s = t.src + (size_t)(16 * (lane >> 4)) * t.ld + 4 * (lane & 15);
#pragma unroll
    for (int i = 0; i < 16; ++i) v[i] = __builtin_nontemporal_load((const f32x4*)(s + (size_t)i * t.ld));
}
__device__ __forceinline__ void p0_store(const P0Tile& t, const f32x4 (&v)[16], LAS unsigned char* scr, int lane) {
#pragma unroll
    for (int j = 0; j < 4; ++j) {
        v4u a, b2;
        a.x = pk2(v[0][j], v[1][j]); a.y = pk2(v[2][j], v[3][j]); a.z = pk2(v[4][j], v[5][j]); a.w = pk2(v[6][j], v[7][j]);
        b2.x = pk2(v[8][j], v[9][j]); b2.y = pk2(v[10][j], v[11][j]); b2.z = pk2(v[12][j], v[13][j]); b2.w = pk2(v[14][j], v[15][j]);
        LAS unsigned char* r = scr + (4 * (lane & 15) + j) * 144 + 32 * (lane >> 4);
        *(LAS v4u*)r = a; *(LAS v4u*)(r + 16) = b2;
    }
    LDS_WAIT(); asm volatile("" ::: "memory");
#pragma unroll
    for (int q = 0; q < 8; ++q) { const int n = 8 * q + (lane >> 3); const v4u o = *(const LAS v4u*)(scr + n * 144 + 16 * (lane & 7));
        __builtin_nontemporal_store(o, (v4u*)(t.dst + (size_t)n * t.K + 8 * (lane & 7))); }
    LDS_WAIT(); asm volatile("" ::: "memory");
}
constexpr int P0_IT_WIN = NL * (INC / 64) * (D / 64);
constexpr int P0_IT_WOUT = NL * (D / 64) * (D / 64);
constexpr int P0_IT_GU = NL * NE * (2 * FF / 64) * (D / 64);
constexpr int P0_IT_DN = NL * NE * (D / 64) * (FF / 64);
constexpr int P0_ITEMS = P0_IT_WIN + P0_IT_WOUT + P0_IT_GU + P0_IT_DN;
__device__ __forceinline__ void p0_nbkb(int r, int KBt, int& nb, int& kb) { nb = r / KBt; kb = r % KBt; }
__device__ __forceinline__ P0Tile p0_tile_of(int it) {
    unsigned char* ws = KP->ws; P0Tile t; int nb, kb;
    if (it < P0_IT_WIN) {
        const int l = it / (P0_IT_WIN / NL), r = it % (P0_IT_WIN / NL); p0_nbkb(r, D / 64, nb, kb);
        const int n0 = nb * 64, pn = n0 >> 8, w = n0 & 255, half = w >> 7, j = w & 127;
        const int sc = (pn < 8 ? 0 : 2048) + half * 1024 + (pn & 7) * 128 + j;
        t.src = KP->w_in + (size_t)l * D * INC + (size_t)(kb * 64) * INC + sc; t.ld = INC; t.dst = (bf16*)(ws + WS_WIN) + ((size_t)l * INC + n0) * D + kb * 64; t.K = D;
        return t;
    }
    it -= P0_IT_WIN;
    if (it < P0_IT_WOUT) {
        const int l = it / (P0_IT_WOUT / NL), r = it % (P0_IT_WOUT / NL); p0_nbkb(r, D / 64, nb, kb);
        const int k0 = kb * 64, sk = (k0 < SCH) ? k0 + CCH : k0 - SCH;
        t.src = KP->w_out + (size_t)l * D * D + (size_t)sk * D + nb * 64; t.ld = D; t.dst = (bf16*)(ws + WS_WOUT) + ((size_t)l * D + nb * 64) * D + k0; t.K = D;
        return t;
    }
    it -= P0_IT_WOUT;
    if (it < P0_IT_GU) {
        const int le = it / 512, r = it % 512; p0_nbkb(r, D / 64, nb, kb);
        const int n0 = nb * 64, pn = n0 >> 8, w = n0 & 255, half = w >> 7, j = w & 127, f0 = pn * 128 + j;
        t.src = (half ? KP->w_up : KP->w_gate) + (size_t)le * D * FF + (size_t)(kb * 64) * FF + f0; t.ld = FF; t.dst = (bf16*)(ws + WS_GU) + ((size_t)le * 2 * FF + n0) * D + kb * 64; t.K = D;
        return t;
    }
    it -= P0_IT_GU;
    {
        const int le = it / 256, r = it % 256; p0_nbkb(r, FF / 64, nb, kb);
        t.src = KP->w_down + (size_t)le * FF * D + (size_t)(kb * 64) * D + nb * 64; t.ld = D; t.dst = (bf16*)(ws + WS_DN) + ((size_t)le * D + nb * 64) * FF + kb * 64; t.K = FF;
    }
    return t;
}
__device__ __forceinline__ void p0_mod_item(Frame& F, int item) {
    PHASE_IDS;
    const int l = item / 96, cbk = item % 96, col = cbk * 128 + 2 * lane;
    LAS float* ca = (LAS float*)F.lds;
    LAS float* red = (LAS float*)(F.lds + 65536);
    for (int i = tid; i < NB * D; i += NTHR) { const int b = i / D, k = i % D; ca[k * 8 + b] = siluf_(KP->c[i]); }
    __syncthreads();
    float a0[8], a1[8];
#pragma unroll
    for (int b = 0; b < 8; ++b) { a0[b] = 0.f; a1[b] = 0.f; }
    const float* w = KP->w_ada + (size_t)l * D * 6 * D + (size_t)(wave * 256) * 6 * D + col;
#pragma unroll 32
    for (int k = 0; k < 256; ++k) {
        const f32x2v wv_ = __builtin_nontemporal_load((const f32x2v*)(w + (size_t)k * 6 * D)); const float2 wv = {wv_.x, wv_.y};
        const f32x4 c0 = *(const LAS f32x4*)(ca + (wave * 256 + k) * 8), c1 = *(const LAS f32x4*)(ca + (wave * 256 + k) * 8 + 4);
#pragma unroll
        for (int b = 0; b < 4; ++b) { a0[b] += c0[b] * wv.x; a1[b] += c0[b] * wv.y; a0[4 + b] += c1[b] * wv.x; a1[4 + b] += c1[b] * wv.y; }
    }
#pragma unroll
    for (int b = 0; b < 8; ++b) { red[(wave * 8 + b) * 128 + 2 * lane] = a0[b]; red[(wave * 8 + b) * 128 + 2 * lane + 1] = a1[b]; }
    __syncthreads();
    for (int o = tid; o < 8 * 128; o += NTHR) { const int b = o >> 7, cc = o & 127; float s = KP->b_ada[l * 6 * D + cbk * 128 + cc];
#pragma unroll
        for (int wv = 0; wv < 8; ++wv) s += red[(wv * 8 + b) * 128 + cc];
        ((float*)(KP->ws + WS_MOD))[((size_t)l * NB + b) * 6 * D + cbk * 128 + cc] = s; }
    __syncthreads();
}
constexpr int RW_FRAGS = NL * 64 * 3;
__device__ __forceinline__ void p0_router_frag(Frame& F, int fi, int lane);
__device__ __forceinline__ void p0_ssm_mats(Frame& F, int lg);
constexpr int P0_FIRST = P0_IT_WIN / NL;
constexpr int CW_P0Q = 1536;
constexpr int G1_SPLIT1 = 208;
constexpr int G1_SPLIT = 176;
__device__ __forceinline__ void p0_prologue(Frame& F) {
    if ((int)blockIdx.x < 192) p0_mod_item(F, blockIdx.x);
    for (int lg = F.G - 1 - (int)blockIdx.x; lg < NL * NG; lg += F.G) p0_ssm_mats(F, lg);
    PHASE_IDS;
    LAS unsigned char* scr = F.lds + wave * 9216;
    const int gw = F.vcu * NWAVES + wave, NGW = F.G * NWAVES;
#pragma unroll 1
    for (int it = gw; it < P0_FIRST; it += NGW) { f32x4 va[16]; const P0Tile ta = p0_tile_of(it); p0_load(ta, va, lane); p0_store(ta, va, scr, lane); }
    for (int fi = gw; fi < RW_FRAGS; fi += NGW) p0_router_frag(F, fi, lane);
}
constexpr int P0_GU0 = P0_IT_WIN + P0_IT_WOUT, P0_DN0 = P0_GU0 + P0_IT_GU;
constexpr int P0_X1 = 8192;
constexpr int P0_W0A = P0_GU0 + P0_IT_GU / 2 + P0_X1 - P0_FIRST;
constexpr int P0_W0 = P0_W0A + P0_IT_DN / 2, P0_W1A = P0_IT_GU / 2 - P0_X1, P0_W1 = P0_W1A + P0_IT_DN / 2;
static_assert(P0_W0 % 4 == 0 && P0_W1 % 4 == 0 && P0_W0A % 4 == 0 && P0_W1A % 4 == 0 && P0_FIRST + P0_W0 + P0_W1 == P0_ITEMS, "queue windows");
__device__ __forceinline__ void p0_queue(Frame& F, int w) {
    PHASE_IDS;
    LAS unsigned char* scr = F.lds + wave * 9216;
    unsigned* cur = ctl_words() + CW_P0Q + 64 * w;
    const int n = w ? P0_W1 : P0_W0, na = w ? P0_W1A : P0_W0A, basea = w ? P0_GU0 + P0_IT_GU / 2 + P0_X1 : P0_FIRST, baseb = (w ? P0_DN0 + P0_IT_DN / 2 : P0_DN0) - na;
#pragma unroll 1
    for (;;) {
        unsigned q = 0u;
        if (lane == 0) q = __hip_atomic_fetch_add(cur, 4u, __ATOMIC_RELAXED, __HIP_MEMORY_SCOPE_AGENT);
        const int q0 = (int)__builtin_amdgcn_readfirstlane(q);
        if (q0 >= n) break;
        const int it0 = q0 + (q0 < na ? basea : baseb);
#pragma unroll 1
        for (int it = it0; it < it0 + 4; ++it) { f32x4 va[16]; const P0Tile ta = p0_tile_of(it); p0_load(ta, va, lane); p0_store(ta, va, scr, lane); }
    }
    __syncthreads();
}


template <int MODE  , bool has_y>
__device__ __forceinline__ void pn_rows(Frame& F, int l, const float* xin, int lp) {
    unsigned char* ws = KP->ws;
    const float* mod = (const float*)(ws + WS_MOD);
    PHASE_IDS;
    const int row0 = F.vcu * 64 + wave * 8, b = (F.vcu * 64) >> 11;
    LAS f32x4* Lg = (LAS f32x4*)F.lds;
    LAS f32x4* Lsh = Lg + 512;
    LAS f32x4* Lg2 = Lg + 1024;
    {
        const int i = tid;
        if (MODE == 0) { const f32x4 g = ((const f32x4*)(KP->norm1_g + l * D))[i]; const f32x4* sh = (const f32x4*)(mod + ((size_t)l * NB + b) * 6 * D); Lg[i] = g * (1.f + sh[D / 4 + i]); Lsh[i] = sh[i]; }
        else Lg[i] = ((const f32x4*)KP->final_g)[i];
        if (has_y) Lg2[i] = ((const f32x4*)(mod + ((size_t)lp * NB + b) * 6 * D + 5 * D))[i];
    }
    __syncthreads();
    f32x4 xa[has_y ? 1 : 8], xb[has_y ? 1 : 8]; v2u ra[has_y ? 8 : 1], rb[has_y ? 8 : 1], ya0[has_y ? 8 : 1], ya1[has_y ? 8 : 1], yb0[has_y ? 8 : 1], yb1[has_y ? 8 : 1], da[1], db[1];
#define PN_LOAD(XF, XR, Y0, Y1, DD, row) do { \
        if constexpr (!has_y) { const f32x4* xr_ = (const f32x4*)(xin + (size_t)(row) * D) + lane; _Pragma("unroll") for (int j = 0; j < 8; ++j) XF[j] = __builtin_nontemporal_load(xr_ + 64 * j); } \
        else { const v2u* x_ = (const v2u*)((const bf16*)(ws + WS_XB) + (size_t)(row) * D) + lane; const v2u* y0_ = (const v2u*)((const bf16*)(ws + WS_Y) + (size_t)(row) * D) + lane; const v2u* y1_ = (const v2u*)((const bf16*)(ws + WS_Y) + ((size_t)T + (row)) * D) + lane; \
            _Pragma("unroll") for (int j = 0; j < 8; ++j) { XR[j] = __builtin_nontemporal_load(x_ + 64 * j); Y0[j] = __builtin_nontemporal_load(y0_ + 64 * j); Y1[j] = __builtin_nontemporal_load(y1_ + 64 * j); } } } while (0)
#define PN_PROC(XF, XR, Y0, Y1, DD, row) do { f32x4 X[8]; \
        if constexpr (!has_y) { _Pragma("unroll") for (int j = 0; j < 8; ++j) X[j] = XF[j]; } \
        else { _Pragma("unroll") for (int j = 0; j < 8; ++j) { const v2u x = XR[j], a = Y0[j], c = Y1[j]; const f32x4 g = Lg2[64 * j + lane]; \
            X[j][0] = __uint_as_float(x.x << 16) + g[0] * (__uint_as_float(a.x << 16) + __uint_as_float(c.x << 16)); X[j][1] = __uint_as_float(x.x & 0xffff0000u) + g[1] * (__uint_as_float(a.x & 0xffff0000u) + __uint_as_float(c.x & 0xffff0000u)); \
            X[j][2] = __uint_as_float(x.y << 16) + g[2] * (__uint_as_float(a.y << 16) + __uint_as_float(c.y << 16)); X[j][3] = __uint_as_float(x.y & 0xffff0000u) + g[3] * (__uint_as_float(a.y & 0xffff0000u) + __uint_as_float(c.y & 0xffff0000u)); } } \
        __builtin_amdgcn_sched_barrier(0); \
        if (MODE == 0) { v2u* xo_ = (v2u*)((bf16*)(ws + WS_XB) + (size_t)(row) * D) + lane; _Pragma("unroll") for (int j = 0; j < 8; ++j) { v2u o; o.x = pk2(X[j][0], X[j][1]); o.y = pk2(X[j][2], X[j][3]); __builtin_nontemporal_store(o, xo_ + 64 * j); } } \
        float ss_ = 0.f; _Pragma("unroll") for (int j = 0; j < 8; ++j) ss_ += (X[j][0] * X[j][0] + X[j][1] * X[j][1]) + (X[j][2] * X[j][2] + X[j][3] * X[j][3]); \
        const float rstd_ = 1.f / sqrtf(wave_sum(ss_) * (1.f / D) + EPS); \
        __builtin_amdgcn_sched_barrier(0); \
        if (MODE == 2) { f32x4* o_ = (f32x4*)(KP->out + (size_t)(row) * D) + lane; _Pragma("unroll") for (int j = 0; j < 8; ++j) __builtin_nontemporal_store(X[j] * rstd_ * Lg[64 * j + lane], o_ + 64 * j); } \
        else { v2u* H_ = (v2u*)((bf16*)(ws + WS_H) + (size_t)(row) * D) + lane; \
            _Pragma("unroll") for (int j = 0; j < 8; ++j) { const f32x4 h = X[j] * rstd_ * Lg[64 * j + lane] + Lsh[64 * j + lane]; v2u o; o.x = pk2(h[0], h[1]); o.y = pk2(h[2], h[3]); H_[64 * j] = o; } } } while (0)
    PN_LOAD(xa, ra, ya0, ya1, da, row0);
#pragma unroll 1
    for (int r = 0; r < 8; r += 2) {
        PN_LOAD(xb, rb, yb0, yb1, db, row0 + r + 1); __builtin_amdgcn_sched_barrier(0);
        PN_PROC(xa, ra, ya0, ya1, da, row0 + r); __builtin_amdgcn_sched_barrier(0);
        if (r + 2 < 8) PN_LOAD(xa, ra, ya0, ya1, da, row0 + r + 2);
        __builtin_amdgcn_sched_barrier(0);
        PN_PROC(xb, rb, yb0, yb1, db, row0 + r + 1); __builtin_amdgcn_sched_barrier(0);
    }
#undef PN_LOAD
#undef PN_PROC
    __syncthreads();
}

__device__ __forceinline__ void p0_router_frag(Frame& F, int fi, int lane) {
    const int l = fi / 192, r = fi % 192, ks = r / 3, cb = r % 3;
    const int col = cb * 16 + (lane & 15), k0 = ks * 32 + 8 * (lane >> 4);
    f16x8 h;
#pragma unroll
    for (int q = 0; q < 8; ++q) { const int k = k0 + q;
        const float w = (col < 4) ? KP->rg_w[((size_t)l * D + k) * NGR + col] : (col < 36) ? KP->re_w[(((size_t)l * NGR + ((col - 4) >> 3)) * D + k) * EPG + ((col - 4) & 7)] : 0.f;
        h[q] = (_Float16)w; }
    ((v4u*)(KP->ws + WS_RW))[(size_t)fi * 64 + lane] = __builtin_bit_cast(v4u, h);
}

constexpr int PN2_TS = 2052;
__device__ __forceinline__ void pn2_phase(Frame& F, int l, bool commit) {
    unsigned char* ws = KP->ws;
    const float* mod = (const float*)(ws + WS_MOD);
    PHASE_IDS;
    LAS float* tile = (LAS float*)F.lds;
    LAS f32x4* Lg = (LAS f32x4*)(F.lds + 16 * PN2_TS * 4);
    LAS f32x4* Lsh = Lg + 512;
    LAS int* lcnt = (LAS int*)(F.lds + L_CNT);
    LAS int* lbase = (LAS int*)(F.lds + L_PTILE);
    LAS int* ent = (LAS int*)(F.lds + L_TAB);
    const int rowbase = F.vcu * 64;
    LAS float* rbias = (LAS float*)(F.lds + 16 * PN2_TS * 4 + 16384);
    v2u xa[2][8], xb[2][8];
#define PN2_LOAD(blk_, p_) do { const int ln_ = fresh_tid(F.wv) & 63; const v2u* xr_ = (const v2u*)((const bf16*)(ws + WS_XB) + (size_t)(rowbase + (blk_) * 16 + 2 * wave) * D) + ln_; \
        _Pragma("unroll") for (int j = 0; j < 8; ++j) { xa[p_][j] = __builtin_nontemporal_load(xr_ + 64 * j); xb[p_][j] = __builtin_nontemporal_load(xr_ + D / 4 + 64 * j); } } while (0)
#define PN2_ROW(XR, r_) do { f32x4 X[8]; _Pragma("unroll") for (int j = 0; j < 8; ++j) { const v2u x = XR[j]; X[j][0] = __uint_as_float(x.x << 16); X[j][1] = __uint_as_float(x.x & 0xffff0000u); X[j][2] = __uint_as_float(x.y << 16); X[j][3] = __uint_as_float(x.y & 0xffff0000u); } \
        float ss_ = 0.f; _Pragma("unroll") for (int j = 0; j < 8; ++j) ss_ += (X[j][0] * X[j][0] + X[j][1] * X[j][1]) + (X[j][2] * X[j][2] + X[j][3] * X[j][3]); \
        const float rstd_ = 1.f / sqrtf(wave_sum(ss_) * (1.f / D) + EPS); v2u* H_ = (v2u*)((bf16*)(ws + WS_H) + (size_t)(rowbase + blk * 16 + (r_)) * D) + lane; \
        _Pragma("unroll") for (int j = 0; j < 8; ++j) { const f32x4 h = X[j] * rstd_ * Lg[64 * j + lane] + Lsh[64 * j + lane]; v2u o; o.x = pk2(h[0], h[1]); o.y = pk2(h[2], h[3]); H_[64 * j] = o; \
            *(LAS f32x4*)(tile + (r_) * PN2_TS + 256 * j + 4 * lane) = h; } } while (0)
    PN2_LOAD(0, 0); PN2_LOAD(1, 1);
    v4u bw[8][3];
    {   const v4u* rw = (const v4u*)(ws + WS_RW) + ((size_t)l * 192 + (size_t)(wave * 8) * 3) * 64 + lane;
#pragma unroll
        for (int q = 0; q < 8; ++q)
#pragma unroll
            for (int cb = 0; cb < 3; ++cb) bw[q][cb] = rw[(size_t)(q * 3 + cb) * 64]; }
    {
        const int b = rowbase >> 11; const f32x4 g = ((const f32x4*)(KP->norm2_g + l * D))[tid]; const f32x4* sh = (const f32x4*)(mod + ((size_t)l * NB + b) * 6 * D + 3 * D);
        Lg[tid] = g * (1.f + sh[D / 4 + tid]); Lsh[tid] = sh[tid];
        if (tid < NE) lcnt[tid] = 0;
        if (tid < 36) rbias[tid] = (tid < 4) ? KP->rg_b[l * NGR + tid] : KP->re_b[l * NGR * EPG + tid - 4];
    }
    __syncthreads();
#pragma unroll
    for (int blk = 0; blk < 4; ++blk) {
        PN2_ROW(xa[blk & 1], 2 * wave); __builtin_amdgcn_sched_barrier(0);
        PN2_ROW(xb[blk & 1], 2 * wave + 1);
        __builtin_amdgcn_sched_barrier(0);
        if (blk + 2 < 4) PN2_LOAD(blk + 2, blk & 1);
        __builtin_amdgcn_sched_barrier(0);
        __syncthreads();
        f32x4 acc[3];
#pragma unroll
        for (int cb = 0; cb < 3; ++cb) acc[cb] = (f32x4){0.f, 0.f, 0.f, 0.f};
#pragma unroll
        for (int q = 0; q < 8; ++q) {
            const LAS float* tp = tile + (lane & 15) * PN2_TS + (wave * 8 + q) * 32 + 8 * (lane >> 4);
            const f32x4 x0 = *(const LAS f32x4*)tp, x1 = *(const LAS f32x4*)(tp + 4);
            f16x8 a_hi, a_lo;
            { const float xs[8] = {x0[0], x0[1], x0[2], x0[3], x1[0], x1[1], x1[2], x1[3]};
#pragma unroll
              for (int jj = 0; jj < 4; ++jj) { const f16x2 hp = __builtin_bit_cast(f16x2, __builtin_amdgcn_cvt_pkrtz(xs[2 * jj], xs[2 * jj + 1]));
                  const f16x2 lp = __builtin_bit_cast(f16x2, __builtin_amdgcn_cvt_pkrtz(xs[2 * jj] - (float)hp[0], xs[2 * jj + 1] - (float)hp[1]));
                  a_hi[2 * jj] = hp[0]; a_hi[2 * jj + 1] = hp[1]; a_lo[2 * jj] = lp[0]; a_lo[2 * jj + 1] = lp[1]; } }
#pragma unroll
            for (int cb = 0; cb < 3; ++cb) { const f16x8 b = __builtin_bit_cast(f16x8, bw[q][cb]);
                acc[cb] = __builtin_amdgcn_mfma_f32_16x16x32_f16(a_hi, b, acc[cb], 0, 0, 0);
                acc[cb] = __builtin_amdgcn_mfma_f32_16x16x32_f16(a_lo, b, acc[cb], 0, 0, 0); }
        }
        __builtin_amdgcn_sched_barrier(0);
        __syncthreads();
        LAS f32x4* part = (LAS f32x4*)F.lds;
#pragma unroll
        for (int cb = 0; cb < 3; ++cb) part[(wave * 3 + cb) * 64 + lane] = acc[cb];
        __syncthreads();
        LAS float* lg = (LAS float*)(F.lds + L_TAB + 2048);
        for (int o = tid; o < 16 * 36; o += NTHR) { const int row = o / 36, col = o % 36, cb = col >> 4, ln = (row >> 2) * 16 + (col & 15); float s = 0.f;
#pragma unroll
            for (int w = 0; w < 8; ++w) s += ((const LAS float*)(part + (w * 3 + cb) * 64 + ln))[row & 3];
            lg[o] = s; }
        __syncthreads();
        if (tid < 16) {
            const int row = rowbase + blk * 16 + tid; const LAS float* q = lg + tid * 36;
            float gl[4]; int gi = 0;
#pragma unroll
            for (int n = 0; n < 4; ++n) gl[n] = q[n] + rbias[n];
#pragma unroll
            for (int n = 1; n < 4; ++n) if (gl[n] > gl[gi]) gi = n;
            float den = 0.f;
#pragma unroll
            for (int n = 0; n < 4; ++n) den += expf(gl[n] - gl[gi]);
            const float gw = 1.f / den;
            float el[8];
#pragma unroll
            for (int e = 0; e < 8; ++e) el[e] = q[4 + gi * 8 + e] + rbias[4 + gi * 8 + e];
            int i1 = 0;
#pragma unroll
            for (int e = 1; e < 8; ++e) if (el[e] > el[i1]) i1 = e;
            int i2 = (i1 == 0) ? 1 : 0;
#pragma unroll
            for (int e = 0; e < 8; ++e) if (e != i1 && el[e] > el[i2]) i2 = e;
            const float e2 = expf(el[i2] - el[i1]); const float w1 = gw / (1.f + e2), w2 = gw * e2 / (1.f + e2);
            float* tw = (float*)(ws + WS_TOKW);
            *(f32x2v*)(tw + row * 2) = (f32x2v){w1, w2};
            const int ea = gi * 8 + i1, eb = gi * 8 + i2;
            const int ra = atomicAdd((int*)(lcnt + ea), 1), rb = atomicAdd((int*)(lcnt + eb), 1);
            LAS int* en = ent + (blk * 32 + 2 * tid) * 3;
            en[0] = ea; en[1] = row * 2; en[2] = ra; en[3] = eb; en[4] = row * 2 + 1; en[5] = rb;
        }
    }
    __syncthreads();
#undef PN2_LOAD
#undef PN2_ROW
    if (commit) {
    if (tid < NE) { const int c = lcnt[tid]; lbase[tid] = c ? (int)__hip_atomic_fetch_add((unsigned*)(ws + WS_CTL) + CW_CNT + l * NE + tid, (unsigned)c, __ATOMIC_RELAXED, __HIP_MEMORY_SCOPE_AGENT) : 0; }
    __syncthreads();
    if (tid < 128) { const LAS int* en = ent + tid * 3; ((unsigned*)(ws + WS_LIST))[(size_t)en[0] * T + lbase[en[0]] + en[2]] = (unsigned)en[1]; }
    }
    __syncthreads();
}

__device__ __forceinline__ void conv_tile(Frame& F, int l, int tile) {
    unsigned char* ws = KP->ws;
    PHASE_IDS;
    const int c0 = 2 * tid;
    const int row0 = tile * 32, t0 = row0 & (SEQ - 1);
    LAS float* C = (LAS float*)F.lds;
    {
        f32x2v w2[CW];
        const float* cw = KP->conv_w + (size_t)l * CW * CCH + c0;
#pragma unroll
        for (int k = 0; k < CW; ++k) w2[k] = *(const f32x2v*)(cw + k * CCH);
        const f32x2v cb = *(const f32x2v*)(KP->conv_b + l * CCH + c0);
        const bf16* Z = (const bf16*)(ws + WS_Z) + c0;
        unsigned zw[62];
#pragma unroll
        for (int i = 0; i < 62; ++i) { const int dt = i - (CW - 1); zw[i] = 0u; if (t0 + dt >= 0) zw[i] = __builtin_nontemporal_load((const unsigned*)(Z + (size_t)(row0 + dt) * CCH)); }
#pragma unroll
        for (int hh = 0; hh < 2; ++hh) {
            f32x2v z2[46];
#pragma unroll
            for (int i = 0; i < 46; ++i) z2[i] = (f32x2v){__uint_as_float(zw[hh * 16 + i] << 16), __uint_as_float(zw[hh * 16 + i] & 0xffff0000u)};
#pragma unroll
            for (int o = 0; o < 16; ++o) { f32x2v a = cb;
#pragma unroll
                for (int k = 0; k < CW; ++k) a = __builtin_elementwise_fma(w2[k], z2[o + k], a);
                *(LAS f32x2v*)(C + (hh * 16 + o) * CCH + c0) = a; }
        }
    }
    __syncthreads();
#pragma unroll
    for (int q = 0; q < 4; ++q) {
        const int tk = wave * 4 + q, row = row0 + tk;
        f32x4 v[4]; float s = 0.f;
#pragma unroll
        for (int j = 0; j < 4; ++j) { v[j] = *(const LAS f32x4*)(C + tk * CCH + 256 * j + 4 * lane); s += (v[j][0] + v[j][1]) + (v[j][2] + v[j][3]); }
        const float mu = wave_sum(s) * (1.f / CCH); float qq = 0.f;
#pragma unroll
        for (int j = 0; j < 4; ++j) { v[j] = v[j] - mu; qq += (v[j][0] * v[j][0] + v[j][1] * v[j][1]) + (v[j][2] * v[j][2] + v[j][3] * v[j][3]); }
        const float rstd = 1.f / sqrtf(wave_sum(qq) * (1.f / CCH) + EPS);
        float q2 = 0.f;
#pragma unroll
        for (int j = 0; j < 4; ++j) { const f32x4 g = *((const f32x4*)(KP->conv_ln_g + l * CCH) + 64 * j + lane), bb = *((const f32x4*)(KP->conv_ln_b + l * CCH) + 64 * j + lane);
#pragma unroll
            for (int i = 0; i < 4; ++i) { const float y = v[j][i] * rstd * g[i] + bb[i]; v[j][i] = siluf_(y); q2 += v[j][i] * v[j][i]; } }
        const float r2 = 1.f / sqrtf(wave_sum(q2) * (1.f / CCH) + EPS);
        v2u* ao = (v2u*)((bf16*)(ws + WS_AO) + (size_t)row * D + SCH) + lane;
#pragma unroll
        for (int j = 0; j < 4; ++j) { const f32x4 g = *((const f32x4*)(KP->onc_g + l * CCH) + 64 * j + lane); v2u o; o.x = pk2(v[j][0] * r2 * g[0], v[j][1] * r2 * g[1]); o.y = pk2(v[j][2] * r2 * g[2], v[j][3] * r2 * g[3]); ao[64 * j] = o; }
    }
    __syncthreads();
}


constexpr size_t SSMM_STRIDE = 256 * 1024, SSMM_WM = 192 * 1024;
__device__ __forceinline__ void p0_ssm_mats(Frame& F, int lg) {
    PHASE_IDS;
    const int l = lg / NG, g = lg % NG;
    LAS float* PWr = (LAS float*)F.lds;
    LAS float* PWi = PWr + 17 * 64;
    LAS float* BBr = PWi + 17 * 64;
    LAS float* BBi = BBr + 1024;
    LAS float* CCr = BBi + 1024;
    LAS float* CCi = CCr + 1024;
    LAS float* KT = CCi + 1024;
    LAS float* DS = KT + 4096;
    const float dt = expf(KP->log_dt[l * NG + g]);
    for (int i = tid; i < 17 * 64; i += NTHR) { const int k = i >> 6, p = i & 63; const float lr = KP->a_re[(l * NG + g) * NP + p], li = KP->a_im[(l * NG + g) * NP + p];
        const float mag = expf(lr * dt * (float)k), ang = li * dt * (float)k; PWr[i] = mag * cosf(ang); PWi[i] = mag * sinf(ang); }
    for (int i = tid; i < 1024; i += NTHR) { const int p = i >> 4, h = i & 15; const float lr = KP->a_re[(l * NG + g) * NP + p], li = KP->a_im[(l * NG + g) * NP + p];
        const float mag = expf(lr * dt), ang = li * dt, ar = mag * cosf(ang), ai = mag * sinf(ang), den = lr * lr + li * li, nr = ar - 1.f, ni = ai;
        const float fr = (nr * lr + ni * li) / den, fi = (ni * lr - nr * li) / den;
        const float br = KP->b_re[((size_t)(l * NG + g) * NP + p) * GW + h], bi = KP->b_im[((size_t)(l * NG + g) * NP + p) * GW + h];
        BBr[i] = fr * br - fi * bi; BBi[i] = fr * bi + fi * br;
        CCr[i] = KP->c_re[(size_t)(l * NG + g) * GW * NP + i]; CCi[i] = KP->c_im[(size_t)(l * NG + g) * GW * NP + i]; }
    if (tid < 16) DS[tid] = KP->ssm_d[l * SCH + g * GW + tid];
    if (tid < 64) { float* a16 = (float*)(KP->ws + WS_A16) + ((size_t)lg * NP + tid) * 2; const float lr = KP->a_re[(l * NG + g) * NP + tid], li = KP->a_im[(l * NG + g) * NP + tid];
        const float mag = expf(lr * dt * 16.f), ang = li * dt * 16.f; a16[0] = mag * cosf(ang); a16[1] = mag * sinf(ang); }
    __syncthreads();
    {
        const int k = tid >> 5, h = (tid >> 1) & 15, h0 = (tid & 1) * 8;
        float acc[8];
#pragma unroll
        for (int j = 0; j < 8; ++j) acc[j] = 0.f;
        for (int p = 0; p < 64; ++p) { const float cr = CCr[h * 64 + p], ci = CCi[h * 64 + p], pr = PWr[k * 64 + p], pi = PWi[k * 64 + p];
            const float zr = cr * pr - ci * pi, zi = cr * pi + ci * pr;
#pragma unroll
            for (int j = 0; j < 8; ++j) acc[j] += zr * BBr[p * 16 + h0 + j] - zi * BBi[p * 16 + h0 + j]; }
#pragma unroll
        for (int j = 0; j < 8; ++j) KT[(k * 16 + h) * 16 + h0 + j] = acc[j];
    }
    __syncthreads();
    v4u* tvf = (v4u*)(KP->ws + WS_SSMM + (size_t)lg * SSMM_STRIDE);
    v4u* wmf = (v4u*)(KP->ws + WS_SSMM + (size_t)lg * SSMM_STRIDE + SSMM_WM);
    const int fr = lane & 15, fq = lane >> 4;
    for (int f = wave; f < 192; f += NWAVES) {
        const int nt = f / 12, ks = f % 12, tau = nt, h = fr; float v[8];
        if (ks < 8) { const int sg = 2 * ks + (fq >> 1), h0 = 8 * (fq & 1), lag = tau - sg;
#pragma unroll
            for (int j = 0; j < 8; ++j) { float x = (lag >= 0) ? KT[(lag * 16 + h) * 16 + h0 + j] : 0.f; if (lag == 0 && h0 + j == h) x += DS[h]; v[j] = x; }
        } else { const int j0 = (ks - 8) * 32 + 8 * fq;
#pragma unroll
            for (int q = 0; q < 4; ++q) { const int p = (j0 >> 1) + q; const float cr = CCr[h * 64 + p], ci = CCi[h * 64 + p], pr = PWr[(tau + 1) * 64 + p], pi = PWi[(tau + 1) * 64 + p];
                v[2 * q] = cr * pr - ci * pi; v[2 * q + 1] = -(cr * pi + ci * pr); }
        }
        tvf[(size_t)f * 64 + lane] = (v4u){pk2(v[0], v[1]), pk2(v[2], v[3]), pk2(v[4], v[5]), pk2(v[6], v[7])};
    }
    for (int f = wave; f < 64; f += NWAVES) {
        const int nt = f >> 3, ks = f & 7, j = nt * 16 + fr, p = j >> 1, c = j & 1, sg = 2 * ks + (fq >> 1), h0 = 8 * (fq & 1); float v[8];
        const float pr = PWr[(15 - sg) * 64 + p], pi = PWi[(15 - sg) * 64 + p];
#pragma unroll
        for (int q = 0; q < 8; ++q) { const float br = BBr[p * 16 + h0 + q], bi = BBi[p * 16 + h0 + q]; v[q] = c ? (pr * bi + pi * br) : (pr * br - pi * bi); }
        wmf[(size_t)f * 64 + lane] = (v4u){pk2(v[0], v[1]), pk2(v[2], v[3]), pk2(v[4], v[5]), pk2(v[6], v[7])};
    }
    __syncthreads();
}

constexpr int SSM_RS = 528;
__device__ __forceinline__ void ssm_unit(Frame& F, int l, int b, int g) {
    PHASE_IDS;
    unsigned char* ws = KP->ws;
    const int fr = lane & 15, fq = lane >> 4, lg = l * NG + g;
    const int ntl = wave, nth = 15 - wave, kl = ntl >> 1, kh = nth >> 1;
    LAS unsigned char* Al = F.lds;
    LAS unsigned char* El = F.lds + 128 * SSM_RS;
    const v4u* tvf = (const v4u*)(ws + WS_SSMM + (size_t)lg * SSMM_STRIDE) + lane;
    const v4u* wmf = (const v4u*)(ws + WS_SSMM + (size_t)lg * SSMM_STRIDE + SSMM_WM) + lane;
    v4u w1[8], tl[4], th[8], sl[4], sh[4];
#pragma unroll
    for (int ks = 0; ks < 8; ++ks) w1[ks] = wmf[(size_t)(wave * 8 + ks) * 64];
#pragma unroll
    for (int ks = 0; ks < 4; ++ks) { tl[ks] = (v4u){0u, 0u, 0u, 0u}; if (ks <= kl) tl[ks] = tvf[(size_t)(ntl * 12 + ks) * 64]; }
#pragma unroll
    for (int ks = 0; ks < 8; ++ks) { th[ks] = (v4u){0u, 0u, 0u, 0u}; if (ks <= kh) th[ks] = tvf[(size_t)(nth * 12 + ks) * 64]; }
#pragma unroll
    for (int ks = 0; ks < 4; ++ks) { sl[ks] = tvf[(size_t)(ntl * 12 + 8 + ks) * 64]; sh[ks] = tvf[(size_t)(nth * 12 + 8 + ks) * 64]; }
    {
        const v4u* src = (const v4u*)((const bf16*)(ws + WS_U) + ((size_t)b * NG + g) * SEQ * GW);
        v4u av[8];
#pragma unroll
        for (int it = 0; it < 8; ++it) av[it] = src[it * NTHR + tid];
#pragma unroll
        for (int it = 0; it < 8; ++it) { const int idx = it * NTHR + tid; *(LAS v4u*)(Al + (idx >> 5) * SSM_RS + (idx & 31) * 16) = av[it]; }
    }
    __syncthreads();
#define SSM_AFR(dst, base, koff) do { _Pragma("unroll") for (int m = 0; m < 8; ++m) dst[m] = *(const LAS bf16x8*)((base) + (m * 16 + fr) * SSM_RS + (koff)); } while (0)
    {
        f32x4 acc[8];
#pragma unroll
        for (int m = 0; m < 8; ++m) acc[m] = (f32x4){0.f, 0.f, 0.f, 0.f};
#pragma unroll
        for (int ks = 0; ks < 8; ++ks) { bf16x8 afr[8]; SSM_AFR(afr, Al, (ks * 32 + 8 * fq) * 2); const bf16x8 bfr = __builtin_bit_cast(bf16x8, w1[ks]);
#pragma unroll
            for (int m = 0; m < 8; ++m) acc[m] = __builtin_amdgcn_mfma_f32_16x16x32_bf16(bfr, afr[m], acc[m], 0, 0, 0); }
#pragma unroll
        for (int m = 0; m < 8; ++m) *(LAS f32x4*)(El + (m * 16 + fr) * SSM_RS + (wave * 16 + 4 * fq) * 4) = acc[m];
    }
    __syncthreads();
    {
        const f32x2v a16 = *(const f32x2v*)((const float*)(ws + WS_A16) + ((size_t)lg * NP + lane) * 2);
        LAS f32x2v* SE = (LAS f32x2v*)(F.lds + 2 * 128 * SSM_RS);
        f32x2v e[16];
#pragma unroll
        for (int c = 0; c < 16; ++c) e[c] = *(const LAS f32x2v*)(El + (wave * 16 + c) * SSM_RS + lane * 8);
        float lr[16], li[16]; float sr = 0.f, si = 0.f;
#pragma unroll
        for (int c = 0; c < 16; ++c) { lr[c] = sr; li[c] = si; const float nr = a16.x * sr - a16.y * si + e[c].x, ni = a16.x * si + a16.y * sr + e[c].y; sr = nr; si = ni; }
        SE[wave * 64 + lane] = (f32x2v){sr, si};
        float pr = a16.x, pi = a16.y;
#pragma unroll
        for (int q = 0; q < 4; ++q) { const float tr = pr * pr - pi * pi, ti = 2.f * pr * pi; pr = tr; pi = ti; }
        __syncthreads();
        float cr = 0.f, ci = 0.f;
        for (int v = 0; v < wave; ++v) { const f32x2v s = SE[v * 64 + lane]; const float nr = pr * cr - pi * ci + s.x, ni = pr * ci + pi * cr + s.y; cr = nr; ci = ni; }
#pragma unroll
        for (int c = 0; c < 16; ++c) { *(LAS unsigned*)(El + (wave * 16 + c) * SSM_RS + lane * 4) = pk2(lr[c] + cr, li[c] + ci);
            const float nr = a16.x * cr - a16.y * ci, ni = a16.x * ci + a16.y * cr; cr = nr; ci = ni; }
    }
    const bf16* SGp = (const bf16*)(ws + WS_SG) + ((size_t)b * NG + g) * SEQ * GW;
    v2u sgw[8][2];
#pragma unroll
    for (int m = 0; m < 8; ++m) { sgw[m][0] = *(const v2u*)(SGp + (size_t)((m * 16 + fr) * 16 + ntl) * GW + 4 * fq); sgw[m][1] = *(const v2u*)(SGp + (size_t)((m * 16 + fr) * 16 + nth) * GW + 4 * fq); }
    __syncthreads();
    {
        f32x4 acc[8][2];
#pragma unroll
        for (int m = 0; m < 8; ++m) { acc[m][0] = (f32x4){0.f, 0.f, 0.f, 0.f}; acc[m][1] = (f32x4){0.f, 0.f, 0.f, 0.f}; }
#pragma unroll
        for (int ks = 0; ks < 8; ++ks) {
            if (ks <= kh) { bf16x8 afr[8]; SSM_AFR(afr, Al, (ks * 32 + 8 * fq) * 2);
                const bf16x8 bh = __builtin_bit_cast(bf16x8, th[ks]);
#pragma unroll
                for (int m = 0; m < 8; ++m) acc[m][1] = __builtin_amdgcn_mfma_f32_16x16x32_bf16(bh, afr[m], acc[m][1], 0, 0, 0);
                if (ks < 4) { if (ks <= kl) { const bf16x8 bl = __builtin_bit_cast(bf16x8, tl[ks < 4 ? ks : 0]);
#pragma unroll
                    for (int m = 0; m < 8; ++m) acc[m][0] = __builtin_amdgcn_mfma_f32_16x16x32_bf16(bl, afr[m], acc[m][0], 0, 0, 0); } }
            }
        }
#pragma unroll
        for (int ks = 0; ks < 4; ++ks) { bf16x8 afr[8]; SSM_AFR(afr, El, (ks * 32 + 8 * fq) * 2);
            const bf16x8 bl = __builtin_bit_cast(bf16x8, sl[ks]), bh = __builtin_bit_cast(bf16x8, sh[ks]);
#pragma unroll
            for (int m = 0; m < 8; ++m) { acc[m][0] = __builtin_amdgcn_mfma_f32_16x16x32_bf16(bl, afr[m], acc[m][0], 0, 0, 0); acc[m][1] = __builtin_amdgcn_mfma_f32_16x16x32_bf16(bh, afr[m], acc[m][1], 0, 0, 0); } }
        bf16* AO = (bf16*)(ws + WS_AO); float* SSQ = (float*)(ws + WS_SSQ);
        const f32x4 gs = *(const f32x4*)(KP->ons_g + l * SCH + g * GW + 4 * fq);
#pragma unroll
        for (int m = 0; m < 8; ++m)
#pragma unroll
            for (int n = 0; n < 2; ++n) {
                const int tok = (m * 16 + fr) * 16 + (n ? nth : ntl);
                const v2u sw = sgw[m][n];
                const float s0 = __uint_as_float(sw.x << 16), s1 = __uint_as_float(sw.x & 0xffff0000u), s2 = __uint_as_float(sw.y << 16), s3 = __uint_as_float(sw.y & 0xffff0000u);
                const float v0 = gelu_tanh(acc[m][n][0]) * s0, v1 = gelu_tanh(acc[m][n][1]) * s1, v2 = gelu_tanh(acc[m][n][2]) * s2, v3 = gelu_tanh(acc[m][n][3]) * s3;
                float sq = (v0 * v0 + v1 * v1) + (v2 * v2 + v3 * v3);
                sq += shfl_xor_fresh(sq, 16); sq += shfl_xor_fresh(sq, 32);
                const size_t row = (size_t)b * SEQ + tok;
                v2u o; o.x = pk2(v0 * gs[0], v1 * gs[1]); o.y = pk2(v2 * gs[2], v3 * gs[3]);
                *(v2u*)(AO + row * D + g * GW + 4 * fq) = o;
                if (fq == 0) SSQ[row * NG + ((g >> 2) & 7) * 8 + (g >> 5) * 4 + (g & 3)] = sq;
            }
    }
#undef SSM_AFR
    __syncthreads();
}

__device__ __forceinline__ void moe_tables(Frame& F, int l) {
    LAS int* pt = (LAS int*)(F.lds + L_PTILE); LAS int* lc = (LAS int*)(F.lds + L_CNT);
    const int tq = fresh_tid(F.wv);
    if (tq < NE) lc[tq] = (int)__hip_atomic_load((const unsigned*)(KP->ws + WS_CTL) + CW_CNT + l * NE + tq, __ATOMIC_RELAXED, __HIP_MEMORY_SCOPE_AGENT);
    __syncthreads();
    if (tq == 0) { int acc = 0; for (int e = 0; e < NE; ++e) { pt[e] = acc; acc += (lc[e] + 255) >> 8; } pt[NE] = acc; }
    __syncthreads();
}

struct MArgs { Ptrs p; int ph_lo, ph_hi, use_bar, mix_mask; };
__global__ void __launch_bounds__(NTHR, 2) mega(MArgs args) {
    extern __shared__ __attribute__((aligned(16))) unsigned char lds_raw[];
    Frame F;
    F.lds = (LAS unsigned char*)lds_raw;
    F.wv = __builtin_amdgcn_readfirstlane((int)threadIdx.x >> 6);
    F.G = gridDim.x; { const int bx = blockIdx.x; F.vcu = (F.G % 8 == 0) ? (bx % 8) * (F.G / 8) + bx / 8 : bx; }
    for (int u = fresh_tid(F.wv); u < (LDS_BYTES - LCTL_OFF) / 4; u += NTHR) ((LAS unsigned*)(F.lds + LCTL_OFF))[u] = 0u;
    __syncthreads();
    XcdBarrier bar; bar.bar = (unsigned*)(KP->ws + WS_CTL) + CW_BAR; bar.x = 0; bar.st = nullptr; bar.wv = F.wv;
    if (args.use_bar) bar = xcd_barrier_post((unsigned*)(KP->ws + WS_CTL) + CW_BAR, (volatile LAS unsigned*)(F.lds + L_MISC) + 8, F.wv);
    const int lo = args.ph_lo, hi = args.ph_hi;
#ifndef PROBE_DUP
#define PROBE_DUP -1
#endif
#define DUPN(k) ((PROBE_DUP == (k)) ? PROBE_REPS : 1)
#define IN(k) (lo <= (k) && (k) < hi)
#define SEAM(k) do { if (IN(k) && IN((k) + 1)) xcd_barrier(bar); } while (0)
    for (int rep = 0; rep < DUPN(7); ++rep) { if (rep) xcd_barrier(bar);
    if (IN(0)) { p0_prologue(F); } }
    SEAM(0);
    for (int l = 0; l < NL; ++l) {
        const int pb = 1 + 7 * l;
#define WSP (KP->ws)
        for (int rep = 0; rep < DUPN(0); ++rep) { if (rep) xcd_barrier(bar);
        if (IN(pb + 0)) { if (l == 0) pn_rows<0, false>(F, l, KP->x, 0); else pn_rows<0, true>(F, l, nullptr, l - 1); } }
        SEAM(pb + 0);
        for (int rep = 0; rep < DUPN(1); ++rep) { if (rep) xcd_barrier(bar);
        if (IN(pb + 1)) {
            unsigned char* ws = WSP;
            pg8::Gemm g{(const bf16*)(ws + WS_H), (const bf16*)(ws + WS_WIN) + (size_t)l * INC * D, T, INC, D};
            const int gg = (F.G > G1_SPLIT) ? (l == 0 ? G1_SPLIT : G1_SPLIT1) : F.G;
            if ((int)blockIdx.x < gg) {
                pg8::StaticOrder S; S.init(T, INC, gg, (int)blockIdx.x);
                EpiIn E{(bf16*)(ws + WS_Z), (bf16*)(ws + WS_U), (bf16*)(ws + WS_SG)};
                pg8::gemm_phase<EpiIn, pg8::StaticOrder, false, D>(F.lds, g, S, E, nullptr, F.wv);
            }
            p0_queue(F, l);
        } }
        SEAM(pb + 1);
        for (int rep = 0; rep < DUPN(2); ++rep) { if (rep) xcd_barrier(bar);
        if (IN(pb + 2)) {
            if (args.mix_mask & 2) for (int u = (int)blockIdx.x; u < ((PROBE_DUP == 21) ? PROBE_REPS : 1) * NB * NG; u += F.G) {
                const int g_ = ((u & 7) << 2) + ((u & 8) << 2) + ((u >> 4) & 3), b_ = ((u >> 6) & 3) + (((u >> 8) & 1) << 2);
                ssm_unit(F, l, b_, g_); }
            if (args.mix_mask & 1) for (int tl = F.vcu; tl < ((PROBE_DUP == 20) ? PROBE_REPS : 1) * (T / 32); tl += F.G) conv_tile(F, l, tl % (T / 32));
        } }
        SEAM(pb + 2);
        for (int rep = 0; rep < DUPN(3); ++rep) { if (rep) xcd_barrier(bar);
        if (IN(pb + 3)) {
            unsigned char* ws = WSP;
            pg8::StaticOrder S; S.init(T, D, F.G, (int)blockIdx.x);
            LAS float* rs = (LAS float*)(F.lds + L_TAB);
            {
                pg8::Unit u0, u1; const bool ok0 = S.next(0, u0), ok1 = S.next(1, u1);
                const int tq = fresh_tid(F.wv), slot = tq >> 8, r = tq & 255; pg8::Unit u; u.pm = slot ? u1.pm : u0.pm;
                if (slot ? ok1 : ok0) { const f32x4* sq = (const f32x4*)((const float*)(ws + WS_SSQ) + (size_t)(u.pm * 256 + r) * NG); float s = 0.f;
#pragma unroll
                    for (int q = 0; q < 16; ++q) { const f32x4 v = sq[q]; s += (v[0] + v[1]) + (v[2] + v[3]); }
                    rs[slot * 256 + r] = 1.f / sqrtf(s * (1.f / SCH) + EPS); }
            }
            __syncthreads();
            pg8::Gemm g{(const bf16*)(ws + WS_AO), (const bf16*)(ws + WS_WOUT) + (size_t)l * D * D, T, D, D};
            EpiOut E{(bf16*)(ws + WS_XB), (const float*)(ws + WS_MOD) + (size_t)l * NB * 6 * D + 2 * D, rs};
            pg8::gemm_phase<EpiOut, pg8::StaticOrder, false, D>(F.lds, g, S, E, nullptr, F.wv);
        } }
        SEAM(pb + 3);
        for (int rep = 0; rep < DUPN(4); ++rep) { if (rep) xcd_barrier(bar);
        if (IN(pb + 4)) pn2_phase(F, l, rep == DUPN(4) - 1); }
        SEAM(pb + 4);
        for (int rep = 0; rep < DUPN(5); ++rep) { if (rep) xcd_barrier(bar);
        if (IN(pb + 5)) {
            unsigned char* ws = WSP;
            moe_tables(F, l);
            const LAS int* pt = (const LAS int*)(F.lds + L_PTILE); const LAS int* lc = (const LAS int*)(F.lds + L_CNT);
            pg8::MoeOrder S{pt, 4, F.G, F.vcu, __builtin_amdgcn_readfirstlane(pt[NE]) * 4, (PROBE_DUP == 15) ? 2 : 1};
            LAS int* tab = (LAS int*)(F.lds + L_TAB);
            {
                LAS int* sinfo = (LAS int*)(F.lds + L_CNT + 128);
#pragma unroll 1
                for (int s = 0; s < 4; ++s) { pg8::Unit u; const bool ok = S.next(s, u); if (fresh_tid(F.wv) == 0) { sinfo[2 * s] = ok ? u.e : -1; sinfo[2 * s + 1] = ok ? u.mloc : 0; } }
                __syncthreads();
                const int tq = fresh_tid(F.wv); unsigned ev[2];
#pragma unroll
                for (int j = 0; j < 2; ++j) { const int sl = (tq >> 8) + 2 * j, e = sinfo[2 * sl], idx = sinfo[2 * sl + 1] * 256 + (tq & 255); ev[j] = 0u;
                    if (e >= 0 && idx < lc[e]) ev[j] = ((const unsigned*)(ws + WS_LIST))[(size_t)e * T + idx]; }
#pragma unroll
                for (int j = 0; j < 2; ++j) tab[((tq >> 8) + 2 * j) * 256 + (tq & 255)] = (int)(ev[j] >> 1);
            }
            __syncthreads();
            pg8::Gemm g{(const bf16*)(ws + WS_H), (const bf16*)(ws + WS_GU) + (size_t)l * NE * 2 * FF * D, 0, 0, D};
            EpiMoe1 E{(bf16*)(ws + WS_HM), CW_HMC + l * 160 * 64};
            pg8::gemm_phase<EpiMoe1, pg8::MoeOrder, true, D>(F.lds, g, S, E, tab, F.wv);
        } }
#if defined(MOE_BARRIER)
        SEAM(pb + 5);
#endif
        for (int rep = 0; rep < DUPN(6); ++rep) { if (rep) xcd_barrier(bar);
        if (IN(pb + 6)) {
            unsigned char* ws = WSP;
            moe_tables(F, l);
            const LAS int* pt = (const LAS int*)(F.lds + L_PTILE); const LAS int* lc = (const LAS int*)(F.lds + L_CNT);
            const int tm_ = __builtin_amdgcn_readfirstlane(pt[NE]), r1_ = (tm_ * 4) % F.G;
#pragma unroll 1
            for (int part = 0; part < 2; ++part) {
                pg8::MoeOrder2 S{pt, 8, F.G, F.vcu, tm_ * 8, r1_, r1_ ? MOE2_PRE : 0, part};
                LAS unsigned* tent = (LAS unsigned*)(F.lds + L_TAB); LAS float* twt = (LAS float*)(F.lds + L_TAB + 7168);
                {
                    LAS int* sinfo = (LAS int*)(F.lds + L_CNT + 128);
                    unsigned* ctl = (unsigned*)(ws + WS_CTL);
                    bool any = false;
#pragma unroll 1
                    for (int s2 = 0; s2 < 8; ++s2) { pg8::Unit u; const bool ok = S.next(s2, u) && s2 < 7; any = any || ok;
                        if (fresh_tid(F.wv) == 0) { sinfo[2 * s2] = ok ? u.e : -1; sinfo[2 * s2 + 1] = ok ? u.mloc : 0; }
                        if (ok && fresh_wave(F.wv) == 0) { unsigned* w = ctl + CW_HMC + (l * 160 + u.pm) * 64; unsigned polls = 0;
                            while ((unsigned)__builtin_amdgcn_readfirstlane(__hip_atomic_load(w, __ATOMIC_RELAXED, __HIP_MEMORY_SCOPE_AGENT)) < 32u) {
                                if (++polls > (1u << 20)) { __hip_atomic_store(ctl + CW_TMO, 1u, __ATOMIC_RELAXED, __HIP_MEMORY_SCOPE_AGENT); break; }
                                __builtin_amdgcn_s_sleep(2); } } }
                    if (any && fresh_wave(F.wv) == 0) { __builtin_amdgcn_fence(__ATOMIC_ACQUIRE, "agent"); asm volatile("s_waitcnt vmcnt(0)" ::: "memory"); }
                    __syncthreads();
                    const int tq = fresh_tid(F.wv); unsigned ev[4]; float wv[4];
#pragma unroll
                    for (int j = 0; j < 4; ++j) { const int sl = (tq >> 8) + 2 * j, e = sinfo[2 * sl], idx = sinfo[2 * sl + 1] * 256 + (tq & 255); ev[j] = ~0u;
                        if (e >= 0 && idx < lc[e]) ev[j] = ((const unsigned*)(ws + WS_LIST))[(size_t)e * T + idx]; }
#pragma unroll
                    for (int j = 0; j < 4; ++j) wv[j] = (ev[j] != ~0u) ? ((const float*)(ws + WS_TOKW))[ev[j]] : 0.f;
#pragma unroll
                    for (int j = 0; j < 4; ++j) { const int sl = (tq >> 8) + 2 * j; if (sl < 7) { tent[sl * 256 + (tq & 255)] = ev[j]; twt[sl * 256 + (tq & 255)] = wv[j]; } }
                }
                __syncthreads();
                pg8::Gemm g{(const bf16*)(ws + WS_HM), (const bf16*)(ws + WS_DN) + (size_t)l * NE * D * FF, 0, 0, FF};
                EpiMoe2 E{(bf16*)(ws + WS_Y), tent, twt};
                pg8::gemm_phase<EpiMoe2, pg8::MoeOrder2, false, FF>(F.lds, g, S, E, nullptr, F.wv);
            }
        } }
        SEAM(pb + 6);
    }
    for (int rep = 0; rep < DUPN(8); ++rep) { if (rep) xcd_barrier(bar);
    if (IN(15)) pn_rows<2, true>(F, 0, nullptr, NL - 1); }
#undef WSP
#undef IN
#undef SEAM
}

extern "C" void kernel_launch(void* const* d_in, const int* in_sizes, int n_in, void* d_out, int out_size, void* d_ws, size_t ws_size, hipStream_t stream) {
    static int grid = 0;
    if (grid == 0) {
        if (n_in != 30 || ws_size < WS_END || out_size != T * D) { fprintf(stderr, "kernel_launch: unexpected n_in %d / out_size %d / ws_size %zu (need %zu)\n", n_in, out_size, ws_size, (size_t)WS_END); grid = -1; return; }
        int dev = 0, cus = 0, per_cu = 0;
        if (hipGetDevice(&dev) != hipSuccess || hipDeviceGetAttribute(&cus, hipDeviceAttributeMultiprocessorCount, dev) != hipSuccess) { grid = -1; return; }
        if (hipFuncSetAttribute((const void*)mega, hipFuncAttributeMaxDynamicSharedMemorySize, LDS_BYTES) != hipSuccess) { fprintf(stderr, "kernel_launch: hipFuncSetAttribute failed\n"); grid = -1; return; }
        if (hipOccupancyMaxActiveBlocksPerMultiprocessor(&per_cu, (const void*)mega, NTHR, LDS_BYTES) != hipSuccess || per_cu < 1) { fprintf(stderr, "kernel_launch: occupancy query reports %d workgroups per CU; nothing launched\n", per_cu); (void)hipGetLastError(); grid = -1; return; }
        if (cus != 256) { fprintf(stderr, "kernel_launch: built for 256 CUs, device has %d; nothing launched\n", cus); grid = -1; return; }
        grid = cus;
    }
    if (grid < 0) return;
    MArgs a{};
    const float** pp = (const float**)&a.p;
    for (int i = 0; i < 30; ++i) pp[i] = (const float*)d_in[i];
    a.p.out = (float*)d_out; a.p.ws = (unsigned char*)d_ws;
    a.ph_lo = 0; a.ph_hi = 16; a.use_bar = 1; a.mix_mask = 3;
    if (hipMemsetAsync((char*)d_ws + WS_CTL, 0, CTL_BYTES, stream) != hipSuccess) { fprintf(stderr, "kernel_launch: memset failed\n"); return; }
    hipLaunchKernelGGL(mega, dim3(grid), dim3(NTHR), LDS_BYTES, stream, a);
    const hipError_t le = hipPeekAtLastError();
    if (le != hipSuccess) fprintf(stderr, "kernel_launch: launch failed: %s\n", hipGetErrorName(le));
}
```
